# Optimizing an MI355X kernel written in HIP

```python
import jax, jax.numpy as jnp
from jax import lax
import numpy as np

D_MODEL = 1024
BATCH = 8
SEQ = 2048
DEPTH = 2
DEC_BATCH = 128
DEC_SEQ = 1
PAST_LEN = 16384
PAGE_SIZE = 128

N_META = 16
HEAD_DIM = 64
D_R = D_MODEL
N_HEADS = D_R // HEAD_DIM
D_C = D_MODEL
CONV_W = 3
LORA_W = 64
LORA_A = 64
LORA_G = 128
D_SHIFT = 3 * D_R + LORA_W + LORA_A + LORA_G
D_PROJ = D_SHIFT + 3 * D_C + 2 * D_MODEL
D_FF = 2816
RMS_EPS = 1e-6
GN_EPS = 64e-5

kernel_name = 'rwkv7_shortconv_macaron_hybrid_step'


def _rmsnorm(x, g):
    xf = x.astype(jnp.float32)
    y = xf * lax.rsqrt(jnp.mean(jnp.square(xf), axis=-1, keepdims=True) + RMS_EPS)
    return (y * g.astype(jnp.float32)).astype(x.dtype)


def _swiglu(x, w_in, w_out):
    gate, up = jnp.split(x @ w_in, 2, axis=-1)
    return (jax.nn.silu(gate) * up) @ w_out


def _wkv_step(S, inp):
    r_t, w_t, k_t, v_t, a_t, b_t = inp
    Sa = jnp.einsum('bhvk,bhk->bhv', S, a_t)
    S = S * w_t[:, :, None, :] + Sa[..., None] * b_t[:, :, None, :] + v_t[..., None] * k_t[:, :, None, :]
    y = jnp.einsum('bhvk,bhk->bhv', S, r_t)
    return S, y


def _mixer(xn, wkv0, shift0, conv0, w_in, mu_shift, w0, w_w2, a0, w_a2, w_g2,
           k_k, k_a, r_k, lnx_w, lnx_b, conv_w, w_o):
    f32 = jnp.float32
    bsz, L, _ = xn.shape
    proj = xn @ w_in
    ps, pc, pg = jnp.split(proj, [D_SHIFT, D_SHIFT + 3 * D_C], axis=-1)

    prev = jnp.concatenate([shift0[:, None, :].astype(ps.dtype), ps[:, :-1]], axis=1)
    xs = (ps + (prev - ps) * mu_shift).astype(f32)
    new_shift = ps[:, -1].astype(shift0.dtype)
    r, k, v, lw, la, lg = jnp.split(
        xs, [D_R, 2 * D_R, 3 * D_R, 3 * D_R + LORA_W, 3 * D_R + LORA_W + LORA_A], axis=-1)
    w_log = -jax.nn.softplus(-(w0.astype(f32) + jnp.tanh(lw) @ w_w2.astype(f32))) - 0.5
    decay = jnp.exp(-jnp.exp(w_log))
    a = jax.nn.sigmoid(a0.astype(f32) + la @ w_a2.astype(f32))
    g = jax.nn.sigmoid(lg) @ w_g2.astype(f32)

    def hs(t):
        return t.reshape(bsz, L, N_HEADS, HEAD_DIM)

    kk = hs(k * k_k.astype(f32))
    kk = kk / jnp.maximum(jnp.sqrt(jnp.sum(jnp.square(kk), axis=-1, keepdims=True)), 1e-12)
    kh = hs(k * (1.0 + (a - 1.0) * k_a.astype(f32)))
    ah, rh, vh, wh = hs(a), hs(r), hs(v), hs(decay)
    seq_in = tuple(jnp.moveaxis(t, 1, 0) for t in (rh, wh, kh, vh, -kk, kk * ah))
    S_T, y = lax.scan(_wkv_step, wkv0.astype(f32), seq_in)
    y = jnp.moveaxis(y, 0, 1)
    mu = jnp.mean(y, axis=-1, keepdims=True)
    var = jnp.mean(jnp.square(y - mu), axis=-1, keepdims=True)
    yn = ((y - mu) * lax.rsqrt(var + GN_EPS)).reshape(bsz, L, D_R) * lnx_w.astype(f32) + lnx_b.astype(f32)
    bonus = (jnp.sum(rh * kh * r_k.astype(f32), axis=-1, keepdims=True) * vh).reshape(bsz, L, D_R)
    y_a = ((yn + bonus) * g).astype(xn.dtype)

    gb, gc, hc = jnp.split(pc, 3, axis=-1)
    u = gc * hc
    u_pad = jnp.concatenate([conv0.astype(u.dtype), u], axis=1)
    z = conv_w[0] * u_pad[:, 0:L] + conv_w[1] * u_pad[:, 1:L + 1] + conv_w[2] * u_pad[:, 2:L + 2]
    new_conv = u_pad[:, -(CONV_W - 1):].astype(conv0.dtype)
    y_b = gb * z

    gate_a, gate_b = jnp.split(pg, 2, axis=-1)
    m = jax.nn.sigmoid(gate_a) * y_a + jax.nn.sigmoid(gate_b) * y_b
    return m @ w_o, S_T.astype(wkv0.dtype), new_shift, new_conv


def _trunk(x, wkv_in, shift_in, conv_in, p):
    new_wkv, new_shift, new_conv = [], [], []
    for l in range(DEPTH):
        x = x + 0.5 * _swiglu(_rmsnorm(x, p['norm_ffn1'][l]), p['ffn1_w_in'][l], p['ffn1_w_out'][l])
        h, s_w, s_s, s_c = _mixer(
            _rmsnorm(x, p['norm_mix'][l]), wkv_in[l], shift_in[l], conv_in[l],
            p['w_in'][l], p['mu_shift'][l], p['w0'][l], p['w_w2'][l], p['a0'][l], p['w_a2'][l],
            p['w_g2'][l], p['k_k'][l], p['k_a'][l], p['r_k'][l], p['lnx_w'][l], p['lnx_b'][l],
            p['conv_w'][l], p['w_o'][l])
        x = x + h
        x = x + 0.5 * _swiglu(_rmsnorm(x, p['norm_ffn2'][l]), p['ffn2_w_in'][l], p['ffn2_w_out'][l])
        new_wkv.append(s_w)
        new_shift.append(s_s)
        new_conv.append(s_c)
    y = _rmsnorm(x, p['norm_final'])
    return y, jnp.stack(new_wkv), jnp.stack(new_shift), jnp.stack(new_conv)


def setup_inputs(seed: int = 0) -> dict:
    key = jax.random.key(seed)
    ks = jax.random.split(key, 28)

    def nrm(k, shape, s):
        return jax.random.normal(k, shape, jnp.float32) * s

    return {
        'x_prompt': nrm(ks[0], (BATCH, SEQ, D_MODEL), 1.0),
        'x_sample': nrm(ks[1], (DEC_BATCH, DEC_SEQ, D_MODEL), 1.0),
        'state_wkv': nrm(ks[2], (DEPTH, DEC_BATCH, N_HEADS, HEAD_DIM, HEAD_DIM), 0.3),
        'state_shift': nrm(ks[3], (DEPTH, DEC_BATCH, D_SHIFT), 1.0),
        'state_conv': nrm(ks[4], (DEPTH, DEC_BATCH, CONV_W - 1, D_C), 1.0),
        'meta_tokens': nrm(ks[5], (N_META, D_MODEL), 1.0),
        'norm_ffn1': 1.0 + nrm(ks[6], (DEPTH, D_MODEL), 0.02),
        'ffn1_w_in': nrm(ks[7], (DEPTH, D_MODEL, 2 * D_FF), D_MODEL ** -0.5),
        'ffn1_w_out': nrm(ks[8], (DEPTH, D_FF, D_MODEL), D_FF ** -0.5),
        'norm_mix': 1.0 + nrm(ks[9], (DEPTH, D_MODEL), 0.02),
        'w_in': nrm(ks[10], (DEPTH, D_MODEL, D_PROJ), D_MODEL ** -0.5),
        'mu_shift': jax.random.uniform(ks[11], (DEPTH, D_SHIFT), jnp.float32),
        'w0': jax.random.uniform(ks[12], (DEPTH, D_R), jnp.float32, minval=-4.0, maxval=1.0),
        'w_w2': nrm(ks[13], (DEPTH, LORA_W, D_R), 0.1 * LORA_W ** -0.5),
        'a0': nrm(ks[14], (DEPTH, D_R), 0.1),
        'w_a2': nrm(ks[15], (DEPTH, LORA_A, D_R), 0.5 * LORA_A ** -0.5),
        'w_g2': nrm(ks[16], (DEPTH, LORA_G, D_R), LORA_G ** -0.5),
        'k_k': 0.85 + nrm(ks[17], (DEPTH, D_R), 0.02),
        'k_a': 1.0 + nrm(ks[18], (DEPTH, D_R), 0.02),
        'r_k': nrm(ks[19], (DEPTH, N_HEADS, HEAD_DIM), 0.1),
        'lnx_w': 1.0 + nrm(ks[20], (DEPTH, D_R), 0.02),
        'lnx_b': nrm(ks[21], (DEPTH, D_R), 0.02),
        'conv_w': nrm(ks[22], (DEPTH, CONV_W, D_C), CONV_W ** -0.5),
        'w_o': nrm(ks[23], (DEPTH, D_MODEL, D_MODEL), D_MODEL ** -0.5),
        'norm_ffn2': 1.0 + nrm(ks[24], (DEPTH, D_MODEL), 0.02),
        'ffn2_w_in': nrm(ks[25], (DEPTH, D_MODEL, 2 * D_FF), D_MODEL ** -0.5),
        'ffn2_w_out': nrm(ks[26], (DEPTH, D_FF, D_MODEL), D_FF ** -0.5),
        'norm_final': 1.0 + nrm(ks[27], (D_MODEL,), 0.02),
    }


def reference(x_prompt, x_sample, state_wkv, state_shift, state_conv, meta_tokens,
              norm_ffn1, ffn1_w_in, ffn1_w_out, norm_mix, w_in, mu_shift, w0, w_w2, a0,
              w_a2, w_g2, k_k, k_a, r_k, lnx_w, lnx_b, conv_w, w_o, norm_ffn2,
              ffn2_w_in, ffn2_w_out, norm_final):
    p = dict(norm_ffn1=norm_ffn1, ffn1_w_in=ffn1_w_in, ffn1_w_out=ffn1_w_out,
             norm_mix=norm_mix, w_in=w_in, mu_shift=mu_shift, w0=w0, w_w2=w_w2, a0=a0,
             w_a2=w_a2, w_g2=w_g2, k_k=k_k, k_a=k_a, r_k=r_k, lnx_w=lnx_w, lnx_b=lnx_b,
             conv_w=conv_w, w_o=w_o, norm_ffn2=norm_ffn2, ffn2_w_in=ffn2_w_in,
             ffn2_w_out=ffn2_w_out, norm_final=norm_final)

    bp = x_prompt.shape[0]
    dt = x_prompt.dtype
    meta = jnp.broadcast_to(meta_tokens.astype(dt)[None], (bp, N_META, D_MODEL))
    xp = jnp.concatenate([meta, x_prompt], axis=1)
    wkv0 = jnp.zeros((DEPTH, bp, N_HEADS, HEAD_DIM, HEAD_DIM), dt)
    shift0 = jnp.zeros((DEPTH, bp, D_SHIFT), dt)
    conv0 = jnp.zeros((DEPTH, bp, CONV_W - 1, D_C), dt)
    yp, p_wkv, p_shift, p_conv = _trunk(xp, wkv0, shift0, conv0, p)
    y_prompt = yp[:, N_META:]

    y_sample, s_wkv, s_shift, s_conv = _trunk(x_sample, state_wkv, state_shift, state_conv, p)

    return (y_prompt, y_sample, p_wkv, p_shift, p_conv, s_wkv, s_shift, s_conv)
```

```cpp
#include <hip/hip_runtime.h>
#include <hip/hip_cooperative_groups.h>
#include <cstdio>
#include <cstdint>
namespace cg = cooperative_groups;

#define LAS __attribute__((address_space(3)))
typedef unsigned short bf16_t;
typedef short bf16x8 __attribute__((ext_vector_type(8)));
typedef float f32x4 __attribute__((ext_vector_type(4)));
typedef unsigned u32x4 __attribute__((ext_vector_type(4)));
typedef unsigned u32x2 __attribute__((ext_vector_type(2)));

constexpr int DM = 1024, NB = 8, SEQ = 2048, NMETA = 16, LP = SEQ + NMETA  , NS = 128;
constexpr int MP = NB * LP  , M = MP + NS  ;
constexpr int DFF = 2816, DSHIFT = 3328, DPROJ = 8448;
constexpr size_t O_YP = 0, O_YS = O_YP + (size_t)NB * SEQ * DM, O_WKVP = O_YS + (size_t)NS * DM, O_SHP = O_WKVP + 2ull * NB * 16 * 4096,
                 O_CVP = O_SHP + 2ull * NB * DSHIFT, O_WKVS = O_CVP + 2ull * NB * 2 * DM, O_SHS = O_WKVS + 2ull * NS * 16 * 4096,
                 O_CVS = O_SHS + 2ull * NS * DSHIFT, O_END = O_CVS + 2ull * NS * 2 * DM;
constexpr size_t SZ_W1 = 5632ull * 1024 * 2, SZ_W2 = 1024ull * 2816 * 2, SZ_WIN = 8448ull * 1024 * 2, SZ_WO = 1024ull * 1024 * 2, SZ_WL = 3072ull * 256 * 2;
constexpr size_t OFF_W1 = 0, OFF_W2 = OFF_W1 + SZ_W1, OFF_WIN = OFF_W2 + SZ_W2, OFF_WO = OFF_WIN + SZ_WIN, OFF_W5 = OFF_WO + SZ_WO, OFF_W6 = OFF_W5 + SZ_W1,
                 OFF_WL = OFF_W6 + SZ_W2, OFF_XLO = OFF_WL + 2 * SZ_WL, OFF_YRAW = OFF_XLO + (size_t)M * DM * 2, OFF_SS = OFF_YRAW + (size_t)M * DM * 2, OFF_BETA = OFF_SS + (size_t)M * 16 * 4,
                 OFF_L = OFF_BETA + (size_t)M * 16 * 4,
                 OFF_BIG = OFF_L + (size_t)M * 256 * 2;
constexpr size_t BLK = (size_t)M * DM * 2, SZ_PS = (size_t)M * DSHIFT * 2;
constexpr size_t OFF_PS = OFF_BIG, OFF_E = OFF_PS + SZ_PS, OFF_A = OFF_E + BLK, OFF_G = OFF_A + BLK, OFF_BAR = OFF_G + BLK, OFF_SA0 = OFF_BAR + 16384, WS_END = OFF_SA0 + (size_t)M * 256 * 2;
constexpr size_t OFF_H = OFF_BIG;
constexpr int LDS_RSTD = 131072 + 512;
constexpr int LDS_BYTES = LDS_RSTD + 8 * 256 * 4;
constexpr int NPHASE = 24;
#ifndef DUP_MASK
#define DUP_MASK 0
#endif

struct Args { const float* in[28]; float* out; unsigned char* ws; int ph_lo, ph_hi; };

typedef __bf16 bf16x2_t __attribute__((ext_vector_type(2)));
typedef float f32x2_t __attribute__((ext_vector_type(2)));
__device__ __forceinline__ unsigned pk2(float lo, float hi) { const f32x2_t v = {lo, hi}; const bf16x2_t b = __builtin_convertvector(v, bf16x2_t); return __builtin_bit_cast(unsigned, b); }
__device__ __forceinline__ float bflo(unsigned u) { return __uint_as_float(u << 16); }
__device__ __forceinline__ float bfhi(unsigned u) { return __uint_as_float(u & 0xffff0000u); }
__device__ __forceinline__ int otid() { int t = threadIdx.x; asm volatile("" : "+v"(t)); return t; }
__device__ __forceinline__ float sigm(float x) { return __builtin_amdgcn_rcpf(1.f + __expf(-x)); }
template <int CTRL> __device__ __forceinline__ float dppf(float x) { return __builtin_bit_cast(float, __builtin_amdgcn_mov_dpp(__builtin_bit_cast(int, x), CTRL, 0xf, 0xf, true)); }
__device__ __forceinline__ float red8(float x) { x += dppf<0xB1>(x); x += dppf<0x4E>(x); x += dppf<0x141>(x); return x; }
__device__ __forceinline__ float red16(float x) { x = red8(x); x += dppf<0x128>(x); return x; }
__device__ __forceinline__ float row_rstd(const float* SS, int row) {
    const f32x4* p = (const f32x4*)(SS + (size_t)row * 16);
    const f32x4 a = p[0], b = p[1], c = p[2], d = p[3];
    const float s = ((a[0] + a[1]) + (a[2] + a[3])) + ((b[0] + b[1]) + (b[2] + b[3])) + ((c[0] + c[1]) + (c[2] + c[3])) + ((d[0] + d[1]) + (d[2] + d[3]));
    return rsqrtf(s * (1.f / 1024.f) + 1e-6f);
}

namespace pg8 {
constexpr int BM = 256, BK = 64, HALF = 128, HTB = HALF * BK * 2, STAGE_BYTES = 8 * HTB, NXCD = 8, WGM = 8;
__host__ __device__ __forceinline__ int lds_byte(int r, int c) { const int st = (r >> 4) * 2 + (c >> 5), rr = r & 15, cc = c & 31, ob = rr * 64 + cc * 2; return st * 1024 + (ob ^ (((ob >> 9) & 1) << 5)); }
__host__ __device__ __forceinline__ void stage_rc(int b, int& R, int& C) { const int st = b / 1024, sb = b % 1024, swz = sb ^ (((sb >> 9) & 1) << 5); R = (st >> 1) * 16 + swz / 64; C = (st & 1) * 32 + (swz % 64) / 2; }
__host__ __device__ __forceinline__ int perm32(int rho) { const int n = rho >> 4, i = rho & 15; return 8 * (i >> 2) + 4 * n + (i & 3); }
struct Unit { int pm, pn; };
struct Gemm { const bf16_t* A; const bf16_t* Bt; int M, N, K, lda; };
struct StaticOrder {
    int nM, nN, nwg, G, c;
    __device__ void init(int M_, int N_, int G_, int c_) { nM = M_ / BM; nN = N_ / BM; nwg = nM * nN; G = G_; c = c_; }
    __device__ bool next(int i, Unit& u) const {
        const long L = (long)i * G + c; if (L >= nwg) return false;
        int wgid = (int)L; { const int q = nwg / NXCD, r = nwg % NXCD, xcd = wgid % NXCD, off = wgid / NXCD; wgid = (xcd < r ? xcd * (q + 1) : r * (q + 1) + (xcd - r) * q) + off; }
        const int nig = WGM * nN, gid = wgid / nig, fm = gid * WGM, gsz = (nM - fm) < WGM ? (nM - fm) : WGM;
        u.pm = fm + ((wgid % nig) % gsz); u.pn = (wgid % nig) / gsz; return true;
    }
};

template <class Epi>
__device__ __forceinline__ void gemm_phase(LAS unsigned char* lds, const Gemm g, const StaticOrder& S, const Epi& E) {
    const int tid = otid(), wid = __builtin_amdgcn_readfirstlane(tid >> 6), lane = tid & 63, wr = wid >> 2, wc = wid & 3, fr = lane & 15, fq = lane >> 4;
    int K = g.K, lda = g.lda; asm volatile("" : "+s"(K), "+s"(lda));
    const int nt = K / BK;
    unsigned voffA[2], voffB[2];
#pragma unroll
    for (int i = 0; i < 2; ++i) { int R, C; stage_rc(tid * 16 + i * 8192, R, C); const int Rb = Epi::PERM ? ((R & ~31) + perm32(R & 31)) : R;
        voffA[i] = (unsigned)(R * lda + C) * 2u; voffB[i] = (unsigned)(Rb * K + C) * 2u; }
    const size_t kstep = (size_t)(BK * 2);
    const size_t hstepA = (size_t)HALF * lda * 2, hstepB = (size_t)HALF * K * 2;
    const size_t tstepA = 2 * hstepA, tstepB = 2 * hstepB;
    const unsigned ldsw = (unsigned)wid * 1024u;
    const int aoff = lds_byte(wr * 64 + fr, fq * 8), boff = lds_byte(wc * 32 + fr, fq * 8);
#define PG8_SA(b, h) (((b) * 2 + (h)) * HTB)
#define PG8_SB(b, h) ((4 + (b) * 2 + (h)) * HTB)
#define PG8_STAGE(bufoff, gbase, voff) do { _Pragma("unroll") for (int _i = 0; _i < 2; ++_i) \
        __builtin_amdgcn_global_load_lds((const unsigned*)((const char*)(gbase) + (voff)[_i]), (LAS unsigned*)(lds + (bufoff) + ldsw + _i * 8192), 16, 0, 0); } while (0)
#define PG8_LDA(dst, b, h) do { _Pragma("unroll") for (int m = 0; m < 4; ++m) _Pragma("unroll") for (int k = 0; k < 2; ++k) dst[m][k] = *(const LAS bf16x8*)(lds + PG8_SA(b, h) + aoff + m * 2048 + k * 1024); } while (0)
#define PG8_LDB(dst, b, h) do { _Pragma("unroll") for (int n = 0; n < 2; ++n) _Pragma("unroll") for (int k = 0; k < 2; ++k) dst[n][k] = *(const LAS bf16x8*)(lds + PG8_SB(b, h) + boff + n * 2048 + k * 1024); } while (0)
#define PG8_MMA(ai, bj, At, Bt) do { __builtin_amdgcn_s_setprio(1); _Pragma("unroll") for (int m = 0; m < 4; ++m) _Pragma("unroll") for (int n = 0; n < 2; ++n) _Pragma("unroll") for (int k = 0; k < 2; ++k) \
        acc[ai][bj][m][n] = __builtin_amdgcn_mfma_f32_16x16x32_bf16(Bt[n][k], At[m][k], acc[ai][bj][m][n], 0, 0, 0); __builtin_amdgcn_s_setprio(0); } while (0)
#define PG8_WAIT_V(n) asm volatile("s_waitcnt vmcnt(" #n ")" ::: "memory")
#define PG8_WAIT_L(n) asm volatile("s_waitcnt lgkmcnt(" #n ")" ::: "memory")
#define PG8_BAR __builtin_amdgcn_s_barrier()
#define PG8_SCHED __builtin_amdgcn_sched_barrier(0)
    Unit cur, nxt; int ui = 0;
    if (!S.next(0, cur)) return;
    f32x4 acc[2][2][4][2];
#pragma unroll
    for (int a = 0; a < 2; ++a)
#pragma unroll
        for (int b = 0; b < 2; ++b)
#pragma unroll
            for (int m = 0; m < 4; ++m)
#pragma unroll
                for (int n = 0; n < 2; ++n) acc[a][b][m][n] = (f32x4){0.f, 0.f, 0.f, 0.f};
    bf16x8 At[4][2], B0[2][2], B1[2][2];
    const char* cA = (const char*)g.A + (size_t)cur.pm * tstepA; const char* cB = (const char*)g.Bt + (size_t)cur.pn * tstepB;
    PG8_STAGE(PG8_SB(0, 0), cB, voffB); PG8_STAGE(PG8_SB(0, 1), cB + hstepB, voffB); PG8_STAGE(PG8_SA(0, 0), cA, voffA); PG8_STAGE(PG8_SA(0, 1), cA + hstepA, voffA);
    if (wr == 1) PG8_BAR;
    PG8_WAIT_V(2); PG8_BAR;
    PG8_STAGE(PG8_SB(1, 0), cB + kstep, voffB); PG8_STAGE(PG8_SA(1, 0), cA + kstep, voffA); PG8_STAGE(PG8_SB(1, 1), cB + hstepB + kstep, voffB);
    PG8_WAIT_V(6); PG8_BAR;
    for (;;) {
        const bool has_next = S.next(ui + 1, nxt);
        const char* nA = has_next ? (const char*)g.A + (size_t)nxt.pm * tstepA : cA; const char* nB = has_next ? (const char*)g.Bt + (size_t)nxt.pn * tstepB : cB;
        for (int t = 0; t < nt; t += 2) {
            const bool last = (t == nt - 2);
            const char* a1 = cA + (size_t)(t + 1) * kstep;
            const char* a2 = last ? nA : cA + (size_t)(t + 2) * kstep; const char* b2 = last ? nB : cB + (size_t)(t + 2) * kstep;
            const char* a3 = a2 + kstep; const char* b3 = b2 + kstep;
            PG8_LDB(B0, 0, 0); PG8_LDB(B1, 0, 1); PG8_SCHED; PG8_LDA(At, 0, 0); PG8_STAGE(PG8_SA(1, 1), a1 + hstepA, voffA);
            PG8_WAIT_V(8); PG8_WAIT_L(0); PG8_BAR; PG8_MMA(0, 0, At, B0); PG8_MMA(0, 1, At, B1); PG8_BAR; PG8_SCHED;
            PG8_LDA(At, 0, 1); PG8_STAGE(PG8_SB(0, 0), b2, voffB); PG8_STAGE(PG8_SB(0, 1), b2 + hstepB, voffB); PG8_STAGE(PG8_SA(0, 0), a2, voffA);
            PG8_WAIT_V(8); PG8_WAIT_L(0); PG8_BAR; PG8_MMA(1, 0, At, B0); PG8_MMA(1, 1, At, B1); PG8_BAR; PG8_SCHED;
            PG8_LDB(B0, 1, 0); PG8_LDB(B1, 1, 1); PG8_SCHED; PG8_LDA(At, 1, 0); PG8_STAGE(PG8_SA(0, 1), a2 + hstepA, voffA);
            PG8_WAIT_V(8); PG8_WAIT_L(0); PG8_BAR; PG8_MMA(0, 0, At, B0); PG8_MMA(0, 1, At, B1); PG8_BAR; PG8_SCHED;
            PG8_LDA(At, 1, 1); PG8_STAGE(PG8_SB(1, 0), b3, voffB); PG8_STAGE(PG8_SB(1, 1), b3 + hstepB, voffB); PG8_STAGE(PG8_SA(1, 0), a3, voffA);
            PG8_WAIT_V(8); PG8_WAIT_L(0); PG8_BAR; PG8_MMA(1, 0, At, B0); PG8_MMA(1, 1, At, B1); PG8_BAR; PG8_SCHED;
        }
        if (wr == 0) PG8_BAR;
        E(acc, cur, wr, wc, fr, fq, ui);
        if (!has_next) break;
#pragma unroll
        for (int a = 0; a < 2; ++a)
#pragma unroll
            for (int b = 0; b < 2; ++b)
#pragma unroll
                for (int m = 0; m < 4; ++m)
#pragma unroll
                    for (int n = 0; n < 2; ++n) acc[a][b][m][n] = (f32x4){0.f, 0.f, 0.f, 0.f};
        cur = nxt; cA = nA; cB = nB; ++ui;
        if (wr == 1) PG8_BAR;
    }
    PG8_WAIT_V(0);
    PG8_BAR;
#undef PG8_SA
#undef PG8_SB
#undef PG8_STAGE
#undef PG8_LDA
#undef PG8_LDB
#undef PG8_MMA
#undef PG8_WAIT_V
#undef PG8_WAIT_L
#undef PG8_BAR
#undef PG8_SCHED
}
}

__device__ __forceinline__ void prep_rstd(LAS float* tab, const float* SS, const pg8::StaticOrder& S) {
    const int tid = otid(), r = tid >> 1, h = tid & 1;
#pragma unroll 1
    for (int i0 = 0; i0 < 8; i0 += 4) {
        f32x4 p0[4], p1[4]; bool ok[4];
#pragma unroll
        for (int q = 0; q < 4; ++q) { pg8::Unit u; ok[q] = S.next(i0 + q, u);
            if (ok[q]) { const float* sp = SS + (size_t)(u.pm * 256 + r) * 16 + h * 8; p0[q] = *(const f32x4*)sp; p1[q] = *(const f32x4*)(sp + 4); } }
#pragma unroll
        for (int q = 0; q < 4; ++q) if (ok[q]) {
            float s = ((p0[q][0] + p0[q][1]) + (p0[q][2] + p0[q][3])) + ((p1[q][0] + p1[q][1]) + (p1[q][2] + p1[q][3]));
            s += dppf<0xB1>(s);
            if (h == 0) tab[(i0 + q) * 256 + r] = rsqrtf(s * (1.f / 1024.f) + 1e-6f);
        }
    }
    __syncthreads();
}
__device__ __forceinline__ void rows_rstd(const LAS float* tab, int ui, int wr, int fr, float (&rs)[2][4]) {
#pragma unroll
    for (int ai = 0; ai < 2; ++ai)
#pragma unroll
        for (int m = 0; m < 4; ++m) rs[ai][m] = tab[(ui & 7) * 256 + ai * 128 + wr * 64 + m * 16 + fr];
}


typedef const f32x4 (&AccRef)[2][2][4][2];

struct EpiFfnIn {
    static constexpr bool PERM = true;
    const LAS float* RT; bf16_t* H;
    __device__ __forceinline__ void operator()(AccRef acc, const pg8::Unit& u, int wr, int wc, int fr, int fq, int ui) const {
        const int row0 = u.pm * 256 + wr * 64 + fr, col0 = u.pn * 128 + wc * 32 + fq * 8;
        float rsv[2][4]; rows_rstd(RT, ui, wr, fr, rsv);
#pragma unroll
        for (int ai = 0; ai < 2; ++ai)
#pragma unroll
            for (int m = 0; m < 4; ++m) {
                __builtin_amdgcn_sched_barrier(0); const int row = row0 + ai * 128 + m * 16; const float rs = rsv[ai][m];
                u32x4 w;
#pragma unroll
                for (int n = 0; n < 2; ++n) {
                    const f32x4 gt = acc[ai][0][m][n] * rs, up = acc[ai][1][m][n] * rs; float h[4];
#pragma unroll
                    for (int i = 0; i < 4; ++i) h[i] = gt[i] * sigm(gt[i]) * up[i];
                    w[2 * n] = pk2(h[0], h[1]); w[2 * n + 1] = pk2(h[2], h[3]);
                }
                *(u32x4*)(H + (size_t)row * DFF + col0) = w;
            }
    }
};

struct EpiRes {
    static constexpr bool PERM = true;
    const bf16_t* XB; bf16_t* XBo; float* SS; float scale;
    __device__ __forceinline__ void operator()(AccRef acc, const pg8::Unit& u, int wr, int wc, int fr, int fq, int ui) const {
        const int row0 = u.pm * 256 + wr * 64 + fr, col0 = u.pn * 256 + wc * 32 + fq * 8;
        u32x4 hi[2][4][2];
#pragma unroll
        for (int ai = 0; ai < 2; ++ai)
#pragma unroll
            for (int m = 0; m < 4; ++m)
#pragma unroll
                for (int bj = 0; bj < 2; ++bj) hi[ai][m][bj] = *(const u32x4*)(XB + (size_t)(row0 + ai * 128 + m * 16) * DM + col0 + bj * 128);
#pragma unroll
        for (int ai = 0; ai < 2; ++ai)
#pragma unroll
            for (int m = 0; m < 4; ++m) {
                __builtin_amdgcn_sched_barrier(0);
                const int row = row0 + ai * 128 + m * 16; float ss = 0.f;
#pragma unroll
                for (int bj = 0; bj < 2; ++bj) {
                    const size_t o = (size_t)row * DM + col0 + bj * 128;
                    float x[8];
#pragma unroll
                    for (int i = 0; i < 4; ++i) { x[2 * i] = bflo(hi[ai][m][bj][i]) + acc[ai][bj][m][i >> 1][(i & 1) * 2] * scale; x[2 * i + 1] = bfhi(hi[ai][m][bj][i]) + acc[ai][bj][m][i >> 1][(i & 1) * 2 + 1] * scale; }
                    u32x4 wh;
#pragma unroll
                    for (int i = 0; i < 4; ++i) { wh[i] = pk2(x[2 * i], x[2 * i + 1]); ss += x[2 * i] * x[2 * i] + x[2 * i + 1] * x[2 * i + 1]; }
                    *(u32x4*)(XBo + o) = wh;
                }
                ss += __shfl_xor(ss, 16); ss += __shfl_xor(ss, 32);
                if (fq == 0) SS[(size_t)row * 16 + u.pn * 4 + wc] = ss;
            }
    }
};

struct EpiPS {
    static constexpr bool PERM = true;
    const LAS float* RT; bf16_t* PS; float* shp; float* shs; bf16_t* SA0;
    __device__ __forceinline__ void operator()(AccRef acc, const pg8::Unit& u, int wr, int wc, int fr, int fq, int ui) const {
        const int row0 = u.pm * 256 + wr * 64 + fr, col0 = u.pn * 256 + wc * 32 + fq * 8;
        float rsv[2][4]; rows_rstd(RT, ui, wr, fr, rsv);
        if (u.pn == 13) {
#pragma unroll
            for (int ai = 0; ai < 2; ++ai)
#pragma unroll
                for (int m = 0; m < 4; ++m) {
                    __builtin_amdgcn_sched_barrier(0); const int row = row0 + ai * 128 + m * 16; const float rs = rsv[ai][m];
#pragma unroll
                    for (int bj = 0; bj < 2; ++bj) {
                        const f32x4 v0 = acc[ai][bj][m][0] * rs, v1 = acc[ai][bj][m][1] * rs;
                        u32x4 w; w[0] = pk2(sigm(v0[0]), sigm(v0[1])); w[1] = pk2(sigm(v0[2]), sigm(v0[3])); w[2] = pk2(sigm(v1[0]), sigm(v1[1])); w[3] = pk2(sigm(v1[2]), sigm(v1[3]));
                        *(u32x4*)(SA0 + (size_t)row * 256 + bj * 128 + wc * 32 + fq * 8) = w;
                    }
                }
            return;
        }
#pragma unroll
        for (int ai = 0; ai < 2; ++ai)
#pragma unroll
            for (int m = 0; m < 4; ++m) {
                __builtin_amdgcn_sched_barrier(0); const int row = row0 + ai * 128 + m * 16; const float rs = rsv[ai][m];
                float* sd = nullptr;
                if (row >= MP) sd = shs + (size_t)(row - MP) * DSHIFT; else { const int b = row / LP; if (row - b * LP == LP - 1) sd = shp + (size_t)b * DSHIFT; }
#pragma unroll
                for (int bj = 0; bj < 2; ++bj) {
                    const int col = col0 + bj * 128;
                    const f32x4 v0 = acc[ai][bj][m][0] * rs, v1 = acc[ai][bj][m][1] * rs;
                    u32x4 w; w[0] = pk2(v0[0], v0[1]); w[1] = pk2(v0[2], v0[3]); w[2] = pk2(v1[0], v1[1]); w[3] = pk2(v1[2], v1[3]);
                    *(u32x4*)(PS + (size_t)row * DSHIFT + col) = w;
                    if (sd) { *(f32x4*)(sd + col) = v0; *(f32x4*)(sd + col + 4) = v1; }
                }
            }
    }
};

struct EpiCG {
    static constexpr bool PERM = true;
    const LAS float* RT; bf16_t *SAb, *Qb, *Ub; float* cvp; float* cvs; const float* conv0;
    __device__ __forceinline__ void operator()(AccRef acc, const pg8::Unit& u, int wr, int wc, int fr, int fq, int ui) const {
        const int row0 = u.pm * 256 + wr * 64 + fr, cw = wc * 32 + fq * 8;
        float rsv[2][4]; rows_rstd(RT, ui, wr, fr, rsv);
        const int pn = u.pn + 1;
        if (pn < 4) {
#pragma unroll
            for (int ai = 0; ai < 2; ++ai)
#pragma unroll
                for (int m = 0; m < 4; ++m) {
                    __builtin_amdgcn_sched_barrier(0); const int row = row0 + ai * 128 + m * 16; const float rs = rsv[ai][m];
#pragma unroll
                    for (int bj = 0; bj < 2; ++bj) {
                        const f32x4 v0 = acc[ai][bj][m][0] * rs, v1 = acc[ai][bj][m][1] * rs;
                        u32x4 w; w[0] = pk2(sigm(v0[0]), sigm(v0[1])); w[1] = pk2(sigm(v0[2]), sigm(v0[3])); w[2] = pk2(sigm(v1[0]), sigm(v1[1])); w[3] = pk2(sigm(v1[2]), sigm(v1[3]));
                        *(u32x4*)(SAb + (size_t)row * DM + pn * 256 + bj * 128 + cw) = w;
                    }
                }
        } else if (pn < 12) {
            const int col = (pn - 4) * 128 + cw;
#pragma unroll
            for (int ai = 0; ai < 2; ++ai)
#pragma unroll
                for (int m = 0; m < 4; ++m) {
                    __builtin_amdgcn_sched_barrier(0); const int row = row0 + ai * 128 + m * 16; const float rs = rsv[ai][m];
                    u32x4 w;
#pragma unroll
                    for (int n = 0; n < 2; ++n) {
                        const f32x4 a = acc[ai][0][m][n] * rs, b = acc[ai][1][m][n] * rs;
                        w[2 * n] = pk2(sigm(a[0]) * b[0], sigm(a[1]) * b[1]); w[2 * n + 1] = pk2(sigm(a[2]) * b[2], sigm(a[3]) * b[3]);
                    }
                    *(u32x4*)(Qb + (size_t)row * DM + col) = w;
                }
        } else {
            const int col = (pn - 12) * 128 + cw;
#pragma unroll
            for (int ai = 0; ai < 2; ++ai)
#pragma unroll
                for (int m = 0; m < 4; ++m) {
                    __builtin_amdgcn_sched_barrier(0); const int row = row0 + ai * 128 + m * 16; const float rs = rsv[ai][m];
                    const f32x4 u0 = (acc[ai][0][m][0] * rs) * (acc[ai][1][m][0] * rs), u1 = (acc[ai][0][m][1] * rs) * (acc[ai][1][m][1] * rs);
                    u32x4 w; w[0] = pk2(u0[0], u0[1]); w[1] = pk2(u0[2], u0[3]); w[2] = pk2(u1[0], u1[1]); w[3] = pk2(u1[2], u1[3]);
                    *(u32x4*)(Ub + (size_t)row * DSHIFT + col) = w;
                    float* cd = nullptr;
                    if (row >= MP) {
                        const int s = row - MP; cd = cvs + (size_t)(s * 2 + 1) * DM + col;
                        const float* cs = conv0 + (size_t)(s * 2 + 1) * DM + col; float* c0 = cvs + (size_t)(s * 2) * DM + col;
                        *(f32x4*)c0 = *(const f32x4*)cs; *(f32x4*)(c0 + 4) = *(const f32x4*)(cs + 4);
                    } else { const int b = row / LP, t = row - b * LP; if (t >= LP - 2) cd = cvp + (size_t)(b * 2 + (t - (LP - 2))) * DM + col; }
                    if (cd) { *(f32x4*)cd = u0; *(f32x4*)(cd + 4) = u1; }
                }
        }
    }
};

struct EpiLora {
    static constexpr bool PERM = true;
    bf16_t *E, *A, *G; const float* w0; const float* a0;
    template <int SEC> __device__ __forceinline__ void run(AccRef acc, bf16_t* dst, const float* bias, int row0, int cb) const {
#pragma unroll
        for (int bj = 0; bj < 2; ++bj) {
            const int col = cb + bj * 128;
            f32x4 b0 = (f32x4){0.f, 0.f, 0.f, 0.f}, b1 = b0;
            if (SEC < 2) { b0 = *(const f32x4*)(bias + col); b1 = *(const f32x4*)(bias + col + 4); }
#pragma unroll
            for (int ai = 0; ai < 2; ++ai)
#pragma unroll
                for (int m = 0; m < 4; ++m) {
                    __builtin_amdgcn_sched_barrier(0); const int row = row0 + ai * 128 + m * 16;
                    const f32x4 v0 = acc[ai][bj][m][0] + b0, v1 = acc[ai][bj][m][1] + b1;
                    u32x4 w;
                    if (SEC == 0) { const float sc = -0.60653065971f;
                        w[0] = pk2(sc * sigm(v0[0]), sc * sigm(v0[1])); w[1] = pk2(sc * sigm(v0[2]), sc * sigm(v0[3])); w[2] = pk2(sc * sigm(v1[0]), sc * sigm(v1[1])); w[3] = pk2(sc * sigm(v1[2]), sc * sigm(v1[3])); }
                    else if (SEC == 1) { w[0] = pk2(sigm(v0[0]), sigm(v0[1])); w[1] = pk2(sigm(v0[2]), sigm(v0[3])); w[2] = pk2(sigm(v1[0]), sigm(v1[1])); w[3] = pk2(sigm(v1[2]), sigm(v1[3])); }
                    else { w[0] = pk2(v0[0], v0[1]); w[1] = pk2(v0[2], v0[3]); w[2] = pk2(v1[0], v1[1]); w[3] = pk2(v1[2], v1[3]); }
                    *(u32x4*)(dst + (size_t)row * DM + col) = w;
                }
        }
    }
    __device__ __forceinline__ void operator()(AccRef acc, const pg8::Unit& u, int wr, int wc, int fr, int fq, int ui) const {
        const int row0 = u.pm * 256 + wr * 64 + fr, sec = u.pn >> 2, cb = (u.pn & 3) * 256 + wc * 32 + fq * 8;
        if (sec == 0) run<0>(acc, E, w0, row0, cb); else if (sec == 1) run<1>(acc, A, a0, row0, cb); else run<2>(acc, G, nullptr, row0, cb);
    }
};

__device__ __forceinline__ int colmap(int MAP, int n) {
    if (MAP == 0) return n;
    if (MAP == 1) { const int pn = n >> 8, w = n & 255, hh = pn * 128 + (w & 127); return (w & 128) ? DFF + hh : hh; }
    if (n < DSHIFT) return n;
    const int np = n - DSHIFT, pn = np >> 8, w = np & 255, j = w & 127, bj = w >> 7;
    if (pn < 4) return 6400 + pn * 256 + w;
    if (pn < 12) { const int ch = (pn - 4) * 128 + j; return bj ? 3328 + ch : 7424 + ch; }
    const int ch = (pn - 12) * 128 + j; return bj ? 5376 + ch : 4352 + ch;
}
__device__ __forceinline__ void conv_weight(LAS float* tile, const float* src, int ldsrc, bf16_t* dst, int N, int K, const float* scale, int MAP, int first, int stride) {
    const int tid = otid(), kt_n = K >> 6, items = (N >> 6) * kt_n;
    f32x4 R[4][2];
#define CW_LOAD(it_) do { _Pragma("unroll") for (int q = 0; q < 4; ++q) { const int itq = (it_) + q * stride; \
        if (itq < items) { const int n0 = (itq / kt_n) << 6, k0 = (itq % kt_n) << 6, c0 = colmap(MAP, n0); \
            _Pragma("unroll") for (int i = 0; i < 2; ++i) { const int f = tid + 512 * i, k = f >> 4, n4 = (f & 15) << 2; \
                R[q][i] = *(const f32x4*)(src + (size_t)(k0 + k) * ldsrc + c0 + n4); } } } } while (0)
    if (first < items) CW_LOAD(first);
    for (int it = first; it < items; it += 4 * stride) {
#pragma unroll
        for (int q = 0; q < 4; ++q) {
            const int itq = it + q * stride;
            if (itq < items) {
                const int k0 = (itq % kt_n) << 6;
#pragma unroll
                for (int i = 0; i < 2; ++i) {
                    const int f = tid + 512 * i, k = f >> 4, n4 = (f & 15) << 2;
                    f32x4 v = R[q][i];
                    if (scale) v *= scale[k0 + k];
                    LAS float* tp = tile + q * 4160 + k * 65 + n4; tp[0] = v[0]; tp[1] = v[1]; tp[2] = v[2]; tp[3] = v[3];
                }
            }
        }
        if (it + 4 * stride < items) CW_LOAD(it + 4 * stride);
        __syncthreads();
#pragma unroll
        for (int q = 0; q < 4; ++q) {
            const int itq = it + q * stride;
            if (itq < items) {
                const int n0 = (itq / kt_n) << 6, k0 = (itq % kt_n) << 6;
                const int n = tid >> 3, kg = (tid & 7) << 3; const LAS float* tp = tile + q * 4160 + kg * 65 + n;
                u32x4 w; w[0] = pk2(tp[0], tp[65]); w[1] = pk2(tp[130], tp[195]); w[2] = pk2(tp[260], tp[325]); w[3] = pk2(tp[390], tp[455]);
                *(u32x4*)(dst + (size_t)(n0 + n) * K + k0 + kg) = w;
            }
        }
        __syncthreads();
    }
#undef CW_LOAD
}
__device__ __forceinline__ void conv_jobs(const Args& a, LAS float* tile, unsigned jobs, int first, int stride) {
    unsigned char* ws = a.ws;
    for (int jb = 0; jb < 12; ++jb) {
        if (!((jobs >> jb) & 1u)) continue;
        const int l = jb / 6, w = jb - l * 6;
        const float* src; const float* scale = nullptr; bf16_t* dst; int ldsrc, N, K, MAP = 0;
        if (w == 0 || w == 4) { src = a.in[w == 0 ? 7 : 25] + (size_t)l * DM * 2 * DFF; ldsrc = 2 * DFF; dst = (bf16_t*)(ws + (w == 0 ? OFF_W1 : OFF_W5)); N = 2 * DFF; K = DM; scale = a.in[w == 0 ? 6 : 24] + l * DM; MAP = 1; }
        else if (w == 1 || w == 5) { src = a.in[w == 1 ? 8 : 26] + (size_t)l * DFF * DM; ldsrc = DM; dst = (bf16_t*)(ws + (w == 1 ? OFF_W2 : OFF_W6)); N = DM; K = DFF; }
        else if (w == 2) { src = a.in[10] + (size_t)l * DM * DPROJ; ldsrc = DPROJ; dst = (bf16_t*)(ws + OFF_WIN); N = DPROJ; K = DM; scale = a.in[9] + l * DM; MAP = 2; }
        else { src = a.in[23] + (size_t)l * DM * DM; ldsrc = DM; dst = (bf16_t*)(ws + OFF_WO); N = DM; K = DM; }
        conv_weight(tile, src, ldsrc, dst, N, K, scale, MAP, first, stride);
    }
}

__device__ __forceinline__ void phase_prologue(const Args& a, LAS float* ldsf) {
    unsigned char* ws = a.ws;
    const int tid = otid(), lane = tid & 63, wid = tid >> 6;
    { bf16_t* XB = (bf16_t*)a.out; float* SS = (float*)(ws + OFF_SS);
      for (int row = blockIdx.x * 8 + wid; row < M; row += gridDim.x * 8) {
          const float* src;
          if (row >= MP) src = a.in[1] + (size_t)(row - MP) * DM;
          else { const int b = row / LP, t = row - b * LP; src = t < NMETA ? a.in[5] + (size_t)t * DM : a.in[0] + ((size_t)b * SEQ + (t - NMETA)) * DM; }
          float ss = 0.f;
#pragma unroll
          for (int i = 0; i < 4; ++i) {
              const int c = lane * 4 + i * 256; const f32x4 v = *(const f32x4*)(src + c);
              u32x2 w; w[0] = pk2(v[0], v[1]); w[1] = pk2(v[2], v[3]); *(u32x2*)(XB + (size_t)row * DM + c) = w;
              ss += (v[0] * v[0] + v[1] * v[1]) + (v[2] * v[2] + v[3] * v[3]);
          }
#pragma unroll
          for (int o = 1; o < 64; o <<= 1) ss += __shfl_xor(ss, o);
          if (lane < 16) SS[(size_t)row * 16 + lane] = lane == 0 ? ss : 0.f;
      } }
    { bf16_t* WL = (bf16_t*)(ws + OFF_WL); const int total = 2 * 32 * 3072;
      for (int i = blockIdx.x * 512 + tid; i < total; i += gridDim.x * 512) {
          const int l = i / (32 * 3072), r = i - l * (32 * 3072), kg = r / 3072, n = r - kg * 3072, sec = n >> 10, ch = n & 1023, k0 = kg * 8;
          float v[8];
#pragma unroll
          for (int jx = 0; jx < 8; ++jx) v[jx] = 0.f;
          if (sec == 0) { if (k0 < 64) {
#pragma unroll
              for (int jx = 0; jx < 8; ++jx) v[jx] = a.in[13][((size_t)l * 64 + k0 + jx) * DM + ch]; } }
          else if (sec == 1) { if (k0 >= 64 && k0 < 128) {
#pragma unroll
              for (int jx = 0; jx < 8; ++jx) v[jx] = a.in[15][((size_t)l * 64 + (k0 - 64) + jx) * DM + ch]; } }
          else { if (k0 >= 128) {
#pragma unroll
              for (int jx = 0; jx < 8; ++jx) v[jx] = a.in[16][((size_t)l * 128 + (k0 - 128) + jx) * DM + ch]; } }
          u32x4 w; w[0] = pk2(v[0], v[1]); w[1] = pk2(v[2], v[3]); w[2] = pk2(v[4], v[5]); w[3] = pk2(v[6], v[7]);
          *(u32x4*)(WL + ((size_t)l * 3072 + n) * 256 + k0) = w;
      } }
}

__device__ __forceinline__ void phase_lbuild(const Args& a, int l) {
    unsigned char* ws = a.ws; const bf16_t* PS = (const bf16_t*)(ws + OFF_PS); bf16_t* L = (bf16_t*)(ws + OFF_L);
    const float* mu = a.in[11] + (size_t)l * DSHIFT + 3072; const float* sh0 = a.in[3] + (size_t)l * NS * DSHIFT;
    const int tid = otid(), jj = tid & 31, j0 = jj * 8;
    const f32x4 m0 = *(const f32x4*)(mu + j0), m1 = *(const f32x4*)(mu + j0 + 4);
    struct LIn { u32x4 cur, pv; f32x4 s0, s1; };
    auto lb_load = [&](int it, LIn& r) {
        const int row = it >> 5;
        r.cur = *(const u32x4*)(PS + (size_t)row * DSHIFT + 3072 + j0); r.pv = (u32x4){0u, 0u, 0u, 0u};
        if (row >= MP) { const float* sp = sh0 + (size_t)(row - MP) * DSHIFT + 3072 + j0; r.s0 = *(const f32x4*)sp; r.s1 = *(const f32x4*)(sp + 4); }
        else { const int b = row / LP, t = row - b * LP; if (t > 0) r.pv = *(const u32x4*)(PS + (size_t)(row - 1) * DSHIFT + 3072 + j0); }
    };
    auto lb_compute = [&](int it, const LIn& r) {
        const int row = it >> 5;
        float c[8], p[8];
#pragma unroll
        for (int i = 0; i < 4; ++i) { c[2 * i] = bflo(r.cur[i]); c[2 * i + 1] = bfhi(r.cur[i]); }
        if (row >= MP) {
#pragma unroll
            for (int i = 0; i < 4; ++i) { p[i] = r.s0[i]; p[4 + i] = r.s1[i]; }
        } else {
#pragma unroll
            for (int i = 0; i < 4; ++i) { p[2 * i] = bflo(r.pv[i]); p[2 * i + 1] = bfhi(r.pv[i]); }
        }
        float o[8];
#pragma unroll
        for (int i = 0; i < 8; ++i) {
            const float mm = i < 4 ? m0[i & 3] : m1[i & 3]; const float xs = c[i] + (p[i] - c[i]) * mm;
            o[i] = jj < 8 ? (1.f - 2.f * __builtin_amdgcn_rcpf(1.f + __expf(2.f * xs))) : (jj < 16 ? xs : sigm(xs));
        }
        u32x4 w; w[0] = pk2(o[0], o[1]); w[1] = pk2(o[2], o[3]); w[2] = pk2(o[4], o[5]); w[3] = pk2(o[6], o[7]);
        *(u32x4*)(L + (size_t)row * 256 + j0) = w;
    };
    const int step = gridDim.x * 512, total = M * 32;
    for (int it = blockIdx.x * 512 + tid; it < total; it += 2 * step) {
        LIn A, B; const bool hasB = it + step < total;
        lb_load(it, A); if (hasB) lb_load(it + step, B);
        lb_compute(it, A); if (hasB) lb_compute(it + step, B);
    }
}

typedef float f32x2 __attribute__((ext_vector_type(2)));
__device__ __forceinline__ void scan_prompt(const Args& a, LAS float* lds, int l, int b, int h, int half) {
    unsigned char* ws = a.ws;
#define SCAN_BAR() asm volatile("s_waitcnt lgkmcnt(0)\n\ts_barrier" ::: "memory")
    const bf16_t* PS = (const bf16_t*)(ws + OFF_PS); const bf16_t* Eb = (const bf16_t*)(ws + OFF_E); const bf16_t* Ab = (const bf16_t*)(ws + OFF_A);
    bf16_t* YR = (bf16_t*)(ws + OFF_YRAW); float* BETA = (float*)(ws + OFF_BETA);
    LAS float* vec = lds; LAS float* ybuf = lds + 2 * 12288; LAS float* beta = ybuf + 2 * 1024; LAS float* scal = beta + 64;
    const int tid = otid(), lane = tid & 63, wid = __builtin_amdgcn_readfirstlane(tid >> 6);
    const size_t rowbase = (size_t)b * LP;
    constexpr int nchunk = (LP + 31) / 32;
    if (wid < 4) {
        const int cg8 = (lane & 7) * 8, rloc = wid * 8 + (lane >> 3), vrow = half * 32 + rloc;
        f32x2 S[4];
#pragma unroll
        for (int j = 0; j < 4; ++j) S[j] = (f32x2){0.f, 0.f};
        SCAN_BAR();
        for (int c = 0; c < nchunk; ++c) {
            const LAS float* vb = vec + (c & 1) * 12288; LAS float* yb = ybuf + (c & 1) * 1024; const LAS float* scb = scal + (c & 1) * 64;
            const int nst = (LP - c * 32) < 32 ? (LP - c * 32) : 32;
#define SV_LOAD(P, s_) do { const LAS float* vp = tp + (s_) * 384;     \
                P##r0 = *(const LAS f32x4*)(vp); P##r1 = *(const LAS f32x4*)(vp + 4); P##w0 = *(const LAS f32x4*)(vp + 64); P##w1 = *(const LAS f32x4*)(vp + 68); \
                P##k0 = *(const LAS f32x4*)(vp + 128); P##k1 = *(const LAS f32x4*)(vp + 132); P##a0 = *(const LAS f32x4*)(vp + 192); P##a1 = *(const LAS f32x4*)(vp + 196); \
                P##b0 = *(const LAS f32x4*)(vp + 256); P##b1 = *(const LAS f32x4*)(vp + 260); P##vv = tv[(s_) * 384]; P##sc = *(const LAS f32x2*)(ts + 2 * (s_)); } while (0)
#define SV_STEP(P, s_) do { \
                const f32x2 rv[4] = {(f32x2){P##r0[0], P##r0[1]}, (f32x2){P##r0[2], P##r0[3]}, (f32x2){P##r1[0], P##r1[1]}, (f32x2){P##r1[2], P##r1[3]}}; \
                const f32x2 wv[4] = {(f32x2){P##w0[0], P##w0[1]}, (f32x2){P##w0[2], P##w0[3]}, (f32x2){P##w1[0], P##w1[1]}, (f32x2){P##w1[2], P##w1[3]}}; \
                const f32x2 kv[4] = {(f32x2){P##k0[0], P##k0[1]}, (f32x2){P##k0[2], P##k0[3]}, (f32x2){P##k1[0], P##k1[1]}, (f32x2){P##k1[2], P##k1[3]}}; \
                const f32x2 av[4] = {(f32x2){P##a0[0], P##a0[1]}, (f32x2){P##a0[2], P##a0[3]}, (f32x2){P##a1[0], P##a1[1]}, (f32x2){P##a1[2], P##a1[3]}}; \
                const f32x2 bv[4] = {(f32x2){P##b0[0], P##b0[1]}, (f32x2){P##b0[2], P##b0[3]}, (f32x2){P##b1[0], P##b1[1]}, (f32x2){P##b1[2], P##b1[3]}}; \
                  \
                f32x2 p = S[0] * av[0], q = S[0] * rv[0]; p = S[1] * av[1] + p; q = S[1] * rv[1] + q; p = S[2] * av[2] + p; q = S[2] * rv[2] + q; p = S[3] * av[3] + p; q = S[3] * rv[3] + q; \
                float sa = p[0] + p[1], yq = q[0] + q[1]; \
                sa += dppf<0xB1>(sa); yq += dppf<0xB1>(yq); sa += dppf<0x4E>(sa); yq += dppf<0x4E>(yq); sa += dppf<0x141>(sa); yq += dppf<0x141>(yq); \
                const f32x2 sa2 = (f32x2){sa, sa}, v2 = (f32x2){P##vv, P##vv}; \
                _Pragma("unroll") for (int j = 0; j < 4; ++j) S[j] = S[j] * wv[j] + (sa2 * bv[j] + v2 * kv[j]); \
                ty[(s_) * 32] = yq + sa * P##sc[0] + P##vv * P##sc[1]; } while (0)
            f32x4 Ar0, Ar1, Aw0, Aw1, Ak0, Ak1, Aa0, Aa1, Ab0, Ab1, Br0, Br1, Bw0, Bw1, Bk0, Bk1, Ba0, Ba1, Bb0, Bb1; float Avv, Bvv; f32x2 Asc, Bsc;
            const LAS float* tp = vb + cg8; const LAS float* tv = vb + 320 + vrow; const LAS float* ts = scb; LAS float* ty = yb + rloc;
            SV_LOAD(A, 0);
            for (int s = 0; s < nst; s += 8) {
                SV_LOAD(B, 1); SV_STEP(A, 0);
                SV_LOAD(A, 2); SV_STEP(B, 1);
                SV_LOAD(B, 3); SV_STEP(A, 2);
                SV_LOAD(A, 4); SV_STEP(B, 3);
                SV_LOAD(B, 5); SV_STEP(A, 4);
                SV_LOAD(A, 6); SV_STEP(B, 5);
                SV_LOAD(B, 7); SV_STEP(A, 6);
                if (s + 8 < nst) SV_LOAD(A, 8);
                SV_STEP(B, 7);
                tp += 8 * 384; tv += 8 * 384; ts += 16; ty += 8 * 32;
            }
#undef SV_LOAD
#undef SV_STEP
            SCAN_BAR();
        }
        { float* dst = a.out + O_WKVP + ((((size_t)l * NB + b) * 16 + h) * 64 + vrow) * 64 + cg8;
          *(f32x4*)dst = (f32x4){S[0][0], S[0][1], S[1][0], S[1][1]}; *(f32x4*)(dst + 4) = (f32x4){S[2][0], S[2][1], S[3][0], S[3][1]}; }
    } else {
        const int ht = tid - 256, tq = ht >> 4, c4 = (ht & 15) * 4, col = h * 64 + c4;
        const float* mus = a.in[11] + (size_t)l * DSHIFT;
        const f32x4 mu_r = *(const f32x4*)(mus + col), mu_k = *(const f32x4*)(mus + 1024 + col), mu_v = *(const f32x4*)(mus + 2048 + col);
        const f32x4 kkc = *(const f32x4*)(a.in[17] + l * DM + col), kac = *(const f32x4*)(a.in[18] + l * DM + col), rkc = *(const f32x4*)(a.in[19] + l * DM + col);
        const u32x2 z2 = (u32x2){0u, 0u};
        u32x2 RG[2][8];
#pragma unroll
        for (int p_ = 0; p_ < 2; ++p_)
#pragma unroll
            for (int q_ = 0; q_ < 8; ++q_) RG[p_][q_] = z2;
#define SCAN_LOAD(cc) do { \
        _Pragma("unroll") for (int p_ = 0; p_ < 2; ++p_) { const int tau = p_ * 16 + tq, t_ = (cc) * 32 + tau; if (t_ < LP) { \
            const bf16_t* bp = PS + (rowbase + t_) * DSHIFT + col; \
            RG[p_][0] = *(const u32x2*)bp; RG[p_][1] = *(const u32x2*)(bp + 1024); RG[p_][2] = *(const u32x2*)(bp + 2048); \
            if (t_ > 0) { RG[p_][3] = *(const u32x2*)(bp - DSHIFT); RG[p_][4] = *(const u32x2*)(bp - DSHIFT + 1024); RG[p_][5] = *(const u32x2*)(bp - DSHIFT + 2048); } \
            else { RG[p_][3] = z2; RG[p_][4] = z2; RG[p_][5] = z2; } \
            const size_t eo = (rowbase + t_) * DM + col; RG[p_][6] = *(const u32x2*)(Eb + eo); RG[p_][7] = *(const u32x2*)(Ab + eo); } } } while (0)
#define SCAN_BUILD(cc) do { LAS float* vb_ = vec + ((cc) & 1) * 12288; LAS float* bb_ = beta + ((cc) & 1) * 32; LAS float* sc_ = scal + ((cc) & 1) * 64; \
        _Pragma("unroll") for (int p_ = 0; p_ < 2; ++p_) { const int tau = p_ * 16 + tq, t_ = (cc) * 32 + tau; if (t_ < LP) { \
            const u32x2 pr = RG[p_][0], pk = RG[p_][1], pv = RG[p_][2], qr = RG[p_][3], qk = RG[p_][4], qv = RG[p_][5], pe = RG[p_][6], pa = RG[p_][7]; \
            float r[4] = {bflo(pr[0]), bfhi(pr[0]), bflo(pr[1]), bfhi(pr[1])}, k[4] = {bflo(pk[0]), bfhi(pk[0]), bflo(pk[1]), bfhi(pk[1])}, v[4] = {bflo(pv[0]), bfhi(pv[0]), bflo(pv[1]), bfhi(pv[1])}; \
            const float xr[4] = {bflo(qr[0]), bfhi(qr[0]), bflo(qr[1]), bfhi(qr[1])}, xk[4] = {bflo(qk[0]), bfhi(qk[0]), bflo(qk[1]), bfhi(qk[1])}, xv[4] = {bflo(qv[0]), bfhi(qv[0]), bflo(qv[1]), bfhi(qv[1])}; \
            const float e[4] = {bflo(pe[0]), bfhi(pe[0]), bflo(pe[1]), bfhi(pe[1])}, aa[4] = {bflo(pa[0]), bfhi(pa[0]), bflo(pa[1]), bfhi(pa[1])}; \
            float kk[4], kh[4], ssq = 0.f, bp_ = 0.f, br_ = 0.f, kr_ = 0.f; \
            _Pragma("unroll") for (int i = 0; i < 4; ++i) { r[i] += (xr[i] - r[i]) * mu_r[i]; k[i] += (xk[i] - k[i]) * mu_k[i]; v[i] += (xv[i] - v[i]) * mu_v[i]; \
                kk[i] = k[i] * kkc[i]; ssq += kk[i] * kk[i]; kh[i] = k[i] * (1.f + (aa[i] - 1.f) * kac[i]); bp_ += r[i] * kh[i] * rkc[i]; br_ += kk[i] * aa[i] * r[i]; kr_ += kh[i] * r[i]; } \
              \
            ssq += dppf<0xB1>(ssq); bp_ += dppf<0xB1>(bp_); br_ += dppf<0xB1>(br_); kr_ += dppf<0xB1>(kr_); \
            ssq += dppf<0x4E>(ssq); bp_ += dppf<0x4E>(bp_); br_ += dppf<0x4E>(br_); kr_ += dppf<0x4E>(kr_); \
            ssq += dppf<0x141>(ssq); bp_ += dppf<0x141>(bp_); br_ += dppf<0x141>(br_); kr_ += dppf<0x141>(kr_); \
            ssq += dppf<0x128>(ssq); bp_ += dppf<0x128>(bp_); br_ += dppf<0x128>(br_); kr_ += dppf<0x128>(kr_); \
            const float inv = fminf(__builtin_amdgcn_rsqf(ssq), 1e12f);     \
            br_ *= inv; \
            LAS float* vp = vb_ + tau * 384 + c4; \
            const float w_[4] = {__expf(e[0]), __expf(e[1]), __expf(e[2]), __expf(e[3])}; \
            *(LAS f32x4*)(vp) = (f32x4){w_[0] * r[0], w_[1] * r[1], w_[2] * r[2], w_[3] * r[3]}; \
            *(LAS f32x4*)(vp + 64) = (f32x4){w_[0], w_[1], w_[2], w_[3]}; \
            *(LAS f32x4*)(vp + 128) = (f32x4){kh[0], kh[1], kh[2], kh[3]}; \
            *(LAS f32x4*)(vp + 192) = (f32x4){-kk[0] * inv, -kk[1] * inv, -kk[2] * inv, -kk[3] * inv}; \
            *(LAS f32x4*)(vp + 256) = (f32x4){kk[0] * inv * aa[0], kk[1] * inv * aa[1], kk[2] * inv * aa[2], kk[3] * inv * aa[3]}; \
            *(LAS f32x4*)(vp + 320) = (f32x4){v[0], v[1], v[2], v[3]}; \
            if ((ht & 15) == 0) { bb_[tau] = bp_; sc_[2 * tau] = br_; sc_[2 * tau + 1] = kr_; } } } } while (0)
#define SCAN_POST(cc) do { const LAS float* yb_ = ybuf + ((cc) & 1) * 1024; const LAS float* bb_ = beta + ((cc) & 1) * 32; \
        const int tau = ht >> 3, r4 = (ht & 7) * 4, t_ = (cc) * 32 + tau; if (t_ < LP) { \
            const f32x4 y4 = *(const LAS f32x4*)(yb_ + tau * 32 + r4); \
            u32x2 w_; w_[0] = pk2(y4[0], y4[1]); w_[1] = pk2(y4[2], y4[3]); \
            *(u32x2*)(YR + (rowbase + t_) * DM + h * 64 + half * 32 + r4) = w_; \
            if (half == 0 && (ht & 7) == 0) BETA[(rowbase + t_) * 16 + h] = bb_[tau]; } } while (0)
        SCAN_LOAD(0);
        SCAN_BUILD(0);
        SCAN_LOAD(1);
        SCAN_BAR();
        for (int c = 0; c < nchunk; ++c) {
            if (c >= 1) SCAN_POST(c - 1);
            if (c + 1 < nchunk) SCAN_BUILD(c + 1);
            if (c + 2 < nchunk) SCAN_LOAD(c + 2);
            SCAN_BAR();
        }
        SCAN_POST(nchunk - 1);
#undef SCAN_LOAD
#undef SCAN_BUILD
#undef SCAN_POST
#undef SCAN_BAR
    }
}

__device__ __forceinline__ void scan_sample(const Args& a, LAS float* lds, int l, int s, int hh) {
    unsigned char* ws = a.ws;
    const bf16_t* PS = (const bf16_t*)(ws + OFF_PS); const bf16_t* Eb = (const bf16_t*)(ws + OFF_E); const bf16_t* Ab = (const bf16_t*)(ws + OFF_A);
    bf16_t* YR = (bf16_t*)(ws + OFF_YRAW); float* BETA = (float*)(ws + OFF_BETA);
    LAS float* vec = lds; LAS float* ybuf = lds + 32 * 384; LAS float* beta = ybuf + 32 * 64;
    const int tid = otid(), lane = tid & 63, wid = tid >> 6;
    const int hl = tid >> 4, c4 = (tid & 15) * 4, head = hh * 8 + hl, col = head * 64 + c4;
    const int rl = lane >> 3, cq = (lane & 7) * 4, vrow = wid * 8 + rl;
    const size_t row = (size_t)MP + s;
    __syncthreads();
    if (tid < 128) {
        const float* mus = a.in[11] + (size_t)l * DSHIFT; const float* sh = a.in[3] + ((size_t)l * NS + s) * DSHIFT;
        const bf16_t* bp = PS + row * DSHIFT + col;
        const u32x2 pr = *(const u32x2*)bp, pk = *(const u32x2*)(bp + 1024), pv = *(const u32x2*)(bp + 2048);
        const f32x4 qr = *(const f32x4*)(sh + col), qk = *(const f32x4*)(sh + 1024 + col), qv = *(const f32x4*)(sh + 2048 + col);
        const f32x4 mu_r = *(const f32x4*)(mus + col), mu_k = *(const f32x4*)(mus + 1024 + col), mu_v = *(const f32x4*)(mus + 2048 + col);
        const f32x4 kkc = *(const f32x4*)(a.in[17] + l * DM + col), kac = *(const f32x4*)(a.in[18] + l * DM + col), rkc = *(const f32x4*)(a.in[19] + l * DM + col);
        const u32x2 pe = *(const u32x2*)(Eb + row * DM + col), pa = *(const u32x2*)(Ab + row * DM + col);
        float r[4], k[4], v[4], e[4], aa[4];
        r[0] = bflo(pr[0]); r[1] = bfhi(pr[0]); r[2] = bflo(pr[1]); r[3] = bfhi(pr[1]);
        k[0] = bflo(pk[0]); k[1] = bfhi(pk[0]); k[2] = bflo(pk[1]); k[3] = bfhi(pk[1]);
        v[0] = bflo(pv[0]); v[1] = bfhi(pv[0]); v[2] = bflo(pv[1]); v[3] = bfhi(pv[1]);
        e[0] = bflo(pe[0]); e[1] = bfhi(pe[0]); e[2] = bflo(pe[1]); e[3] = bfhi(pe[1]);
        aa[0] = bflo(pa[0]); aa[1] = bfhi(pa[0]); aa[2] = bflo(pa[1]); aa[3] = bfhi(pa[1]);
        float kk[4], kh[4], ssq = 0.f, bpv = 0.f;
#pragma unroll
        for (int i = 0; i < 4; ++i) {
            r[i] += (qr[i] - r[i]) * mu_r[i]; k[i] += (qk[i] - k[i]) * mu_k[i]; v[i] += (qv[i] - v[i]) * mu_v[i];
            kk[i] = k[i] * kkc[i]; ssq += kk[i] * kk[i]; kh[i] = k[i] * (1.f + (aa[i] - 1.f) * kac[i]); bpv += r[i] * kh[i] * rkc[i];
        }
        ssq = red16(ssq); bpv = red16(bpv);
        const float inv = 1.f / fmaxf(sqrtf(ssq), 1e-12f);
        LAS float* vp = vec + hl * 384 + c4;
        *(LAS f32x4*)(vp) = (f32x4){r[0], r[1], r[2], r[3]};
        *(LAS f32x4*)(vp + 64) = (f32x4){__expf(e[0]), __expf(e[1]), __expf(e[2]), __expf(e[3])};
        *(LAS f32x4*)(vp + 128) = (f32x4){kh[0], kh[1], kh[2], kh[3]};
        *(LAS f32x4*)(vp + 192) = (f32x4){-kk[0] * inv, -kk[1] * inv, -kk[2] * inv, -kk[3] * inv};
        *(LAS f32x4*)(vp + 256) = (f32x4){kk[0] * inv * aa[0], kk[1] * inv * aa[1], kk[2] * inv * aa[2], kk[3] * inv * aa[3]};
        *(LAS f32x4*)(vp + 320) = (f32x4){v[0], v[1], v[2], v[3]};
        if ((tid & 15) == 0) beta[hl] = bpv;
    }
    __syncthreads();
    f32x4 st0[8], st1[8];
#pragma unroll
    for (int h8 = 0; h8 < 8; ++h8) {
        const float* sp = a.in[2] + ((((size_t)l * NS + s) * 16 + hh * 8 + h8) * 64 + vrow) * 64 + cq;
        st0[h8] = *(const f32x4*)sp; st1[h8] = *(const f32x4*)(sp + 32);
    }
#pragma unroll
    for (int h8 = 0; h8 < 8; ++h8) {
        const int h = hh * 8 + h8;
        const size_t so = ((((size_t)l * NS + s) * 16 + h) * 64 + vrow) * 64 + cq;
        const f32x4 s0 = st0[h8], s1 = st1[h8];
        float S[8] = {s0[0], s0[1], s0[2], s0[3], s1[0], s1[1], s1[2], s1[3]};
        const LAS float* vp = vec + h8 * 384 + cq;
        const f32x4 r0 = *(const LAS f32x4*)(vp), r1 = *(const LAS f32x4*)(vp + 32);
        const f32x4 w0 = *(const LAS f32x4*)(vp + 64), w1 = *(const LAS f32x4*)(vp + 96);
        const f32x4 k0 = *(const LAS f32x4*)(vp + 128), k1 = *(const LAS f32x4*)(vp + 160);
        const f32x4 a0 = *(const LAS f32x4*)(vp + 192), a1 = *(const LAS f32x4*)(vp + 224);
        const f32x4 b0 = *(const LAS f32x4*)(vp + 256), b1 = *(const LAS f32x4*)(vp + 288);
        const float vv = vec[h8 * 384 + 320 + vrow];
        float sa = 0.f;
#pragma unroll
        for (int j = 0; j < 4; ++j) { sa += S[j] * a0[j]; sa += S[4 + j] * a1[j]; }
        sa = red8(sa);
        float y = 0.f;
#pragma unroll
        for (int j = 0; j < 4; ++j) {
            S[j] = S[j] * w0[j] + sa * b0[j] + vv * k0[j]; S[4 + j] = S[4 + j] * w1[j] + sa * b1[j] + vv * k1[j];
            y += S[j] * r0[j]; y += S[4 + j] * r1[j];
        }
        y = red8(y);
        if ((lane & 7) == 0) ybuf[h8 * 64 + vrow] = y;
        float* dp = a.out + O_WKVS + so;
        *(f32x4*)dp = (f32x4){S[0], S[1], S[2], S[3]}; *(f32x4*)(dp + 32) = (f32x4){S[4], S[5], S[6], S[7]};
    }
    __syncthreads();
    if (tid < 128) {
        const f32x4 y4 = *(const LAS f32x4*)(ybuf + hl * 64 + c4);
        u32x2 w; w[0] = pk2(y4[0], y4[1]); w[1] = pk2(y4[2], y4[3]);
        *(u32x2*)(YR + row * DM + col) = w;
        if ((tid & 15) == 0) BETA[row * 16 + head] = beta[hl];
    }
}

__device__ __forceinline__ void phase_mix(const Args& a, int l) {
    unsigned char* ws = a.ws; bf16_t* PS = (bf16_t*)(ws + OFF_PS);
    const bf16_t* SAb = (const bf16_t*)(ws + OFF_E); const bf16_t* Qb = (const bf16_t*)(ws + OFF_A); const bf16_t* Ub = (const bf16_t*)(ws + OFF_PS) + 1024;
    const bf16_t* YR = (const bf16_t*)(ws + OFF_YRAW); const float* BETA = (const float*)(ws + OFF_BETA); const bf16_t* SA0 = (const bf16_t*)(ws + OFF_SA0);
    const float* cw = a.in[22] + (size_t)l * 3 * DM; const float* conv0 = a.in[4] + (size_t)l * NS * 2 * DM;
    const float* muv = a.in[11] + (size_t)l * DSHIFT + 2048; const float* sh0 = a.in[3] + (size_t)l * NS * DSHIFT + 2048;
    const float* lnw = a.in[20] + l * DM; const float* lnb = a.in[21] + l * DM;
    const int tid = otid();
    const int c8 = (tid & 127) * 8;
    float pm_[8], pw_[8], pb_[8], c0_[8], c1_[8], c2_[8];
    { const f32x4 a0 = *(const f32x4*)(muv + c8), a1 = *(const f32x4*)(muv + c8 + 4), b0 = *(const f32x4*)(lnw + c8), b1 = *(const f32x4*)(lnw + c8 + 4), d0 = *(const f32x4*)(lnb + c8), d1 = *(const f32x4*)(lnb + c8 + 4);
      const f32x4 e0 = *(const f32x4*)(cw + c8), e1 = *(const f32x4*)(cw + c8 + 4), f0 = *(const f32x4*)(cw + DM + c8), f1 = *(const f32x4*)(cw + DM + c8 + 4), g0 = *(const f32x4*)(cw + 2 * DM + c8), g1 = *(const f32x4*)(cw + 2 * DM + c8 + 4);
#pragma unroll
      for (int i = 0; i < 4; ++i) { pm_[i] = a0[i]; pm_[4 + i] = a1[i]; pw_[i] = b0[i]; pw_[4 + i] = b1[i]; pb_[i] = d0[i]; pb_[4 + i] = d1[i]; c0_[i] = e0[i]; c0_[4 + i] = e1[i]; c1_[i] = f0[i]; c1_[4 + i] = f1[i]; c2_[i] = g0[i]; c2_[4 + i] = g1[i]; } }
    struct MixIn { u32x4 g4, yr, vr, sa, q, u0, p1, p2, pv; f32x4 x0, x1, y0, y1, s0, s1; float bt; };
    auto mix_load = [&](int it, MixIn& r) {
        const int row = it >> 7;
        r.g4 = *(const u32x4*)((const bf16_t*)(ws + OFF_G) + (size_t)row * DM + c8);
        r.yr = *(const u32x4*)(YR + (size_t)row * DM + c8); r.vr = *(const u32x4*)(PS + (size_t)row * DSHIFT + 2048 + c8);
        r.sa = c8 < 256 ? *(const u32x4*)(SA0 + (size_t)row * 256 + c8) : *(const u32x4*)(SAb + (size_t)row * DM + c8);
        r.q = *(const u32x4*)(Qb + (size_t)row * DM + c8); r.u0 = *(const u32x4*)(Ub + (size_t)row * DSHIFT + c8);
        r.bt = BETA[(size_t)row * 16 + (c8 >> 6)];
        r.p1 = (u32x4){0u, 0u, 0u, 0u}; r.p2 = r.p1; r.pv = r.p1;
        if (row >= MP) {
            const float* c1 = conv0 + (size_t)((row - MP) * 2 + 1) * DM + c8; const float* c0 = conv0 + (size_t)((row - MP) * 2) * DM + c8;
            const float* sp = sh0 + (size_t)(row - MP) * DSHIFT + c8;
            r.x0 = *(const f32x4*)c1; r.x1 = *(const f32x4*)(c1 + 4); r.y0 = *(const f32x4*)c0; r.y1 = *(const f32x4*)(c0 + 4); r.s0 = *(const f32x4*)sp; r.s1 = *(const f32x4*)(sp + 4);
        } else {
            const int b = row / LP, t = row - b * LP;
            if (t >= 1) { r.p1 = *(const u32x4*)(Ub + (size_t)(row - 1) * DSHIFT + c8); r.pv = *(const u32x4*)(PS + (size_t)(row - 1) * DSHIFT + 2048 + c8); }
            if (t >= 2) r.p2 = *(const u32x4*)(Ub + (size_t)(row - 2) * DSHIFT + c8);
        }
    };
    auto mix_compute = [&](int it, const MixIn& r) {
        const int row = it >> 7;
        float u1[8], u2[8], vp[8];
        if (row >= MP) {
#pragma unroll
            for (int i = 0; i < 4; ++i) { u1[i] = r.x0[i]; u1[4 + i] = r.x1[i]; u2[i] = r.y0[i]; u2[4 + i] = r.y1[i]; vp[i] = r.s0[i]; vp[4 + i] = r.s1[i]; }
        } else {
#pragma unroll
            for (int i = 0; i < 4; ++i) { u1[2 * i] = bflo(r.p1[i]); u1[2 * i + 1] = bfhi(r.p1[i]); u2[2 * i] = bflo(r.p2[i]); u2[2 * i + 1] = bfhi(r.p2[i]); vp[2 * i] = bflo(r.pv[i]); vp[2 * i + 1] = bfhi(r.pv[i]); }
        }
        float y[8];
#pragma unroll
        for (int i = 0; i < 4; ++i) { y[2 * i] = bflo(r.yr[i]); y[2 * i + 1] = bfhi(r.yr[i]); }
        float s1 = ((y[0] + y[1]) + (y[2] + y[3])) + ((y[4] + y[5]) + (y[6] + y[7]));
        s1 = red8(s1);
        const float mean = s1 * (1.f / 64.f);
        float s2 = 0.f;
#pragma unroll
        for (int i = 0; i < 8; ++i) { y[i] -= mean; s2 += y[i] * y[i]; }
        s2 = red8(s2);
        const float rstd = rsqrtf(s2 * (1.f / 64.f) + 64e-5f);
        float o[8];
#pragma unroll
        for (int i = 0; i < 8; ++i) {
            const int w = i >> 1; const bool hi = i & 1;
            const float vraw = hi ? bfhi(r.vr[w]) : bflo(r.vr[w]);
            const float vv = vraw + (vp[i] - vraw) * pm_[i];
            const float sv = hi ? bfhi(r.sa[w]) : bflo(r.sa[w]), qv = hi ? bfhi(r.q[w]) : bflo(r.q[w]), uv = hi ? bfhi(r.u0[w]) : bflo(r.u0[w]);
            o[i] = (y[i] * rstd * pw_[i] + pb_[i] + r.bt * vv);
            const float z = c0_[i] * u2[i] + c1_[i] * u1[i] + c2_[i] * uv;
            y[i] = qv * z; u1[i] = sv;
        }
        u32x4 w;
#pragma unroll
        for (int i = 0; i < 4; ++i) { const float m0 = u1[2 * i] * (o[2 * i] * bflo(r.g4[i])) + y[2 * i], m1 = u1[2 * i + 1] * (o[2 * i + 1] * bfhi(r.g4[i])) + y[2 * i + 1]; w[i] = pk2(m0, m1); }
        *(u32x4*)(PS + (size_t)row * DSHIFT + c8) = w;
    };
    const int step = gridDim.x * 512, total = M * 128;
    for (int it = blockIdx.x * 512 + tid; it < total; it += 2 * step) {
        MixIn A, B;
        const bool hasB = it + step < total;
        mix_load(it, A);
        if (hasB) mix_load(it + step, B);
        mix_compute(it, A);
        if (hasB) mix_compute(it + step, B);
    }
}

__device__ __forceinline__ void phase_final(const Args& a) {
    unsigned char* ws = a.ws; const bf16_t* XB = (const bf16_t*)(ws + OFF_E);
    const float* SS = (const float*)(ws + OFF_SS); const float* nf = a.in[27];
    const int tid = otid(), lane = tid & 63, wid = tid >> 6;
    f32x4 g[4];
#pragma unroll
    for (int i = 0; i < 4; ++i) g[i] = *(const f32x4*)(nf + lane * 4 + i * 256);
    auto dst_of = [&](int row) -> float* {
        if (row >= M) return nullptr;
        if (row >= MP) return a.out + O_YS + (size_t)(row - MP) * DM;
        const int b = row / LP, t = row - b * LP; if (t < NMETA) return nullptr;
        return a.out + O_YP + ((size_t)b * SEQ + (t - NMETA)) * DM; };
    for (int row = blockIdx.x * 8 + wid; row < M; row += 2 * gridDim.x * 8) {
        const int rowB = row + gridDim.x * 8;
        float* dA = dst_of(row); float* dB = dst_of(rowB);
        u32x2 hA[4], hB[4]; float rsA = 0.f, rsB = 0.f;
        if (dA) { rsA = row_rstd(SS, row);
#pragma unroll
            for (int i = 0; i < 4; ++i) hA[i] = *(const u32x2*)(XB + (size_t)row * DM + lane * 4 + i * 256); }
        if (dB) { rsB = row_rstd(SS, rowB);
#pragma unroll
            for (int i = 0; i < 4; ++i) hB[i] = *(const u32x2*)(XB + (size_t)rowB * DM + lane * 4 + i * 256); }
        if (dA) {
#pragma unroll
            for (int i = 0; i < 4; ++i) { const f32x4 v = (f32x4){bflo(hA[i][0]), bfhi(hA[i][0]), bflo(hA[i][1]), bfhi(hA[i][1])}; *(f32x4*)(dA + lane * 4 + i * 256) = v * rsA * g[i]; } }
        if (dB) {
#pragma unroll
            for (int i = 0; i < 4; ++i) { const f32x4 v = (f32x4){bflo(hB[i][0]), bfhi(hB[i][0]), bflo(hB[i][1]), bfhi(hB[i][1])}; *(f32x4*)(dB + lane * 4 + i * 256) = v * rsB * g[i]; } }
    }
}

__device__ __forceinline__ void gemm_tail_res(LAS float* ldsf, const bf16_t* A, int lda, const bf16_t* Bt, int K, const bf16_t* XB, bf16_t* XBo, float* SS, float scale) {
    const int tid = otid(), lane = tid & 63, wid = tid >> 6;
    const int kw = K >> 3;
    for (int su = blockIdx.x; su < 256; su += gridDim.x) {
        const int row0 = 16384 + (su >> 4) * 16, col0 = (su & 15) * 64;
        f32x4 acc[4];
#pragma unroll
        for (int n = 0; n < 4; ++n) acc[n] = (f32x4){0.f, 0.f, 0.f, 0.f};
        const bf16_t* ap = A + (size_t)(row0 + (lane & 15)) * lda + wid * kw + (lane >> 4) * 8;
        const bf16_t* bp = Bt + (size_t)(col0 + (lane & 15)) * K + wid * kw + (lane >> 4) * 8;
        for (int ks = 0; ks < kw; ks += 32) {
            const bf16x8 af = *(const bf16x8*)(ap + ks);
#pragma unroll
            for (int n = 0; n < 4; ++n) { const bf16x8 bfr = *(const bf16x8*)(bp + (size_t)n * 16 * K + ks); acc[n] = __builtin_amdgcn_mfma_f32_16x16x32_bf16(af, bfr, acc[n], 0, 0, 0); }
        }
#pragma unroll
        for (int n = 0; n < 4; ++n)
#pragma unroll
            for (int j = 0; j < 4; ++j) ldsf[wid * 1024 + ((lane >> 4) * 4 + j) * 64 + n * 16 + (lane & 15)] = acc[n][j];
        __syncthreads();
        { const int r = tid >> 5, c = (tid & 31) * 2; float s0 = 0.f, s1 = 0.f;
#pragma unroll
          for (int w = 0; w < 8; ++w) { const f32x2 v = *(const LAS f32x2*)(ldsf + w * 1024 + r * 64 + c); s0 += v[0]; s1 += v[1]; }
          const size_t o = (size_t)(row0 + r) * DM + col0 + c;
          const unsigned hi = *(const unsigned*)(XB + o);
          f32x2 x; x[0] = bflo(hi) + scale * s0; x[1] = bfhi(hi) + scale * s1;
          *(unsigned*)(XBo + o) = pk2(x[0], x[1]);
          float ss = x[0] * x[0] + x[1] * x[1]; ss = red16(ss); ss += __shfl_xor(ss, 16);
          if ((tid & 31) == 0) SS[(size_t)(row0 + r) * 16 + (su & 15)] = ss; }
        __syncthreads();
    }
}

#define XB_TMO      128
#define XB_XCNT(j)  (256  + 64 * (j))
#define XB_XSUB(j)  (1280 + 64 * (j))
#define XB_XGEN(j)  (2304 + 64 * (j))
#define XB_TOP      3328
#define XB_TOPGEN   3392
#define XCD_BAR_WORDS 3456
#define XB_SPIN_CAP (1u << 18)
__device__ __forceinline__ unsigned xb_ld(unsigned* p)              { return __hip_atomic_load(p, __ATOMIC_RELAXED, __HIP_MEMORY_SCOPE_AGENT); }
__device__ __forceinline__ unsigned xb_add(unsigned* p, unsigned v) { return __hip_atomic_fetch_add(p, v, __ATOMIC_RELAXED, __HIP_MEMORY_SCOPE_AGENT); }
__device__ __forceinline__ unsigned xb_xcc_id() { return (unsigned)__builtin_amdgcn_s_getreg((3 << 11) | 20) & 0xFu; }
#define XB_SPIN(cond, bar) do { unsigned _sp = 0; while (cond) { __builtin_amdgcn_s_sleep(1); \
    if ((++_sp & 255u) == 0u) { if (xb_ld(&(bar)[XB_TMO])) break; if (_sp > XB_SPIN_CAP) { atomicAdd(&(bar)[XB_TMO], 1u); break; } } } } while (0)
struct XcdBarrier { unsigned* bar; unsigned x; volatile LAS unsigned* st; };
__device__ __forceinline__ XcdBarrier xcd_barrier_post(unsigned* bar, volatile LAS unsigned* st) {
    XcdBarrier b; b.bar = bar; b.x = xb_xcc_id(); b.st = st;
    if (threadIdx.x == 0) (void)xb_add(&bar[XB_XCNT(b.x)], 1u);
    return b;
}
__device__ __forceinline__ void xcd_barrier_complete(unsigned* bar, unsigned x, unsigned& nloc, unsigned& nx) {
    const unsigned G = gridDim.x * gridDim.y * gridDim.z;
    unsigned sum, cnt, mine, sp = 0u;
    for (;;) {
        sum = 0u; cnt = 0u; mine = 0u;
#pragma unroll
        for (unsigned j = 0; j < 16; ++j) { const unsigned c = xb_ld(&bar[XB_XCNT(j)]); sum += c; cnt += (c > 0u) ? 1u : 0u; mine = (j == x) ? c : mine; }
        if (sum == G) break;
        __builtin_amdgcn_s_sleep(1);
        if ((++sp & 255u) == 0u) { if (xb_ld(&bar[XB_TMO])) break; if (sp > XB_SPIN_CAP) { atomicAdd(&bar[XB_TMO], 1u); break; } }
    }
    nloc = mine > 0u ? mine : 1u; nx = cnt > 0u ? cnt : 1u;
}
__device__ __forceinline__ void xcd_barrier(const XcdBarrier& b) {
    asm volatile("s_waitcnt vmcnt(0)" ::: "memory");
    __syncthreads();
    if (threadIdx.x == 0) {
        unsigned* bar = b.bar;
        __builtin_amdgcn_s_waitcnt(0);
        unsigned nloc = b.st[0], nx = b.st[1];
        if (nloc == 0u) { xcd_barrier_complete(bar, b.x, nloc, nx); b.st[0] = nloc; b.st[1] = nx; }
        const unsigned old = xb_add(&bar[XB_XSUB(b.x)], 1u);
        const unsigned gen = old / nloc;
        if (old + 1u == (gen + 1u) * nloc) {
            __builtin_amdgcn_fence(__ATOMIC_RELEASE, "agent");
            asm volatile("s_waitcnt vmcnt(0)" ::: "memory");
            const unsigned og = xb_add(&bar[XB_TOP], 1u);
            const unsigned tg = og / nx;
            if (og + 1u == (tg + 1u) * nx) xb_add(&bar[XB_TOPGEN], 1u);
            else XB_SPIN(xb_ld(&bar[XB_TOPGEN]) == tg, bar);
            __builtin_amdgcn_fence(__ATOMIC_ACQUIRE, "agent");
            xb_add(&bar[XB_XGEN(b.x)], 1u);
            asm volatile("s_waitcnt vmcnt(0)" ::: "memory");
        } else {
            XB_SPIN(xb_ld(&bar[XB_XGEN(b.x)]) == gen, bar);
            __builtin_amdgcn_fence(__ATOMIC_ACQUIRE, "agent");
            asm volatile("s_waitcnt vmcnt(0)" ::: "memory");
        }
    }
    __syncthreads();
}

__global__ void __launch_bounds__(512, 2) hybrid_fwd(Args a) {
    extern __shared__ __attribute__((aligned(16))) unsigned char shm_raw[];
    LAS unsigned char* lds = (LAS unsigned char*)shm_raw;
    LAS float* ldsf = (LAS float*)shm_raw;
    cg::grid_group grid = cg::this_grid();
    unsigned char* ws = a.ws;
    volatile LAS unsigned* bst = (volatile LAS unsigned*)(shm_raw + 131072);
    if (threadIdx.x == 0) { bst[0] = 0u; bst[1] = 0u; }
    __syncthreads();
    const XcdBarrier xb = xcd_barrier_post((unsigned*)(ws + OFF_BAR), bst);
    bf16_t* XB = (bf16_t*)a.out; float* SS = (float*)(ws + OFF_SS);
    LAS float* RT = (LAS float*)(shm_raw + LDS_RSTD);
    pg8::StaticOrder S;
    for (int ph = a.ph_lo; ph < a.ph_hi; ++ph) {
      int reps = 1;
#if DUP_MASK
      { const int i_ = (ph - 1) % 11, l_ = (ph - 1) / 11; (void)l_;
        if (ph == 0) { if (DUP_MASK & 1) reps = 2; }
        else if (ph != NPHASE - 1) { if (((DUP_MASK & 2) && (i_ == 0 || i_ == 9)) || ((DUP_MASK & 4) && i_ == 2) || ((DUP_MASK & 8) && i_ == 3) || ((DUP_MASK & 16) && i_ == 4) || ((DUP_MASK & 32) && i_ == 6) || ((DUP_MASK & 64) && i_ == 5) || ((DUP_MASK & 128) && i_ == 7 && l_ == 1)) reps = 2; } }
#endif
      for (int rep = 0; rep < reps; ++rep) {
        if (ph == 0) phase_prologue(a, ldsf);
        else if (ph == NPHASE - 1) phase_final(a);
        else {
            const int l = (ph - 1) / 11, i = (ph - 1) % 11;
            { const int Nph = (i == 0 || i == 9) ? 2 * DFF : (i == 2 ? DSHIFT + 256 : (i == 6 ? 4864 : 0));
              if (Nph) { S.init(M, Nph, gridDim.x, blockIdx.x); prep_rstd(RT, SS, S); } }
            switch (i) {
            case 0: case 9: {
                pg8::Gemm g{XB, (const bf16_t*)(ws + (i == 0 ? OFF_W1 : OFF_W5)), M, 2 * DFF, DM, DM};
                S.init(M, 2 * DFF, gridDim.x, blockIdx.x);
                EpiFfnIn E{RT, (bf16_t*)(ws + OFF_H)};
                pg8::gemm_phase<EpiFfnIn>(lds, g, S, E);
            } break;
            case 1: case 8: case 10: {
                const bool wo = (i == 8);
                pg8::Gemm g{(const bf16_t*)(ws + (wo ? OFF_PS : OFF_H)), (const bf16_t*)(ws + (i == 1 ? OFF_W2 : (wo ? OFF_WO : OFF_W6))), M, DM, wo ? DM : DFF, wo ? DSHIFT : DFF};
                S.init(M - 256, DM, gridDim.x, blockIdx.x);
                const bool fin = (l == 1 && i == 10);
                bf16_t* xbo = fin ? (bf16_t*)(ws + OFF_E) : XB;
                EpiRes E{XB, xbo, SS, wo ? 1.f : 0.5f};
                pg8::gemm_phase<EpiRes>(lds, g, S, E);
                gemm_tail_res(ldsf, g.A, g.lda, g.Bt, g.K, XB, xbo, SS, wo ? 1.f : 0.5f);
            } break;
            case 2: {
                pg8::Gemm g{XB, (const bf16_t*)(ws + OFF_WIN), M, DSHIFT + 256, DM, DM};
                S.init(M, DSHIFT + 256, gridDim.x, blockIdx.x);
                EpiPS E{RT, (bf16_t*)(ws + OFF_PS), a.out + O_SHP + (size_t)l * NB * DSHIFT, a.out + O_SHS + (size_t)l * NS * DSHIFT, (bf16_t*)(ws + OFF_SA0)};
                pg8::gemm_phase<EpiPS>(lds, g, S, E);
            } break;
            case 3:
                phase_lbuild(a, l);
                break;
            case 4: {
                pg8::Gemm g{(const bf16_t*)(ws + OFF_L), (const bf16_t*)(ws + OFF_WL + (size_t)l * SZ_WL), M, 3072, 256, 256};
                S.init(M, 3072, gridDim.x, blockIdx.x);
                EpiLora E{(bf16_t*)(ws + OFF_E), (bf16_t*)(ws + OFF_A), (bf16_t*)(ws + OFF_G), a.in[12] + l * DM, a.in[14] + l * DM};
                pg8::gemm_phase<EpiLora>(lds, g, S, E);
            } break;
            case 5:
                for (int u = blockIdx.x; u < 512; u += gridDim.x) { if (u < 256) scan_prompt(a, ldsf, l, u >> 5, (u >> 1) & 15, u & 1); else scan_sample(a, ldsf, l, (u - 256) >> 1, u & 1); }
                break;
            case 6: {
                pg8::Gemm g{XB, (const bf16_t*)(ws + OFF_WIN + (size_t)(DSHIFT + 256) * DM * 2), M, 4864, DM, DM};
                S.init(M, 4864, gridDim.x, blockIdx.x);
                EpiCG E{RT, (bf16_t*)(ws + OFF_E), (bf16_t*)(ws + OFF_A), (bf16_t*)(ws + OFF_PS) + 1024, a.out + O_CVP + (size_t)l * NB * 2 * DM, a.out + O_CVS + (size_t)l * NS * 2 * DM,
                        a.in[4] + (size_t)l * NS * 2 * DM};
                pg8::gemm_phase<EpiCG>(lds, g, S, E);
            } break;
            case 7:
                phase_mix(a, l);
                break;
            }
        }
      }
        {
            unsigned jobs = 0u;
            if (ph == 0) jobs = 0x3Fu;
            else if (ph != NPHASE - 1) {
                const int l = (ph - 1) / 11, i = (ph - 1) % 11;
                if (l == 0 && i == 7) jobs = 0x7u << 6;
                else if (l == 1 && i == 3) jobs = 0x38u << 6;
            }
            if (jobs) conv_jobs(a, ldsf, jobs, blockIdx.x, gridDim.x);
        }
        if (ph + 1 < a.ph_hi) { if (a.ph_lo < 0) grid.sync(); else xcd_barrier(xb); }
    }
}

extern "C" void kernel_launch(void* const* d_in, const int* in_sizes, int n_in, void* d_out, int out_size, void* d_ws, size_t ws_size, hipStream_t stream) {
    static int grid = 0;
    if (grid == 0) {
        if (n_in != 28 || (size_t)out_size != O_END || ws_size < WS_END) {
            fprintf(stderr, "kernel_launch: unexpected shapes: n_in %d out_size %d ws_size %zu (need %zu)\n", n_in, out_size, ws_size, (size_t)WS_END); grid = -1; return; }
        int dev = 0, cus = 0, per_cu = 0;
        if (hipGetDevice(&dev) != hipSuccess || hipDeviceGetAttribute(&cus, hipDeviceAttributeMultiprocessorCount, dev) != hipSuccess) { grid = -1; return; }
        if (hipFuncSetAttribute((const void*)hybrid_fwd, hipFuncAttributeMaxDynamicSharedMemorySize, LDS_BYTES) != hipSuccess) { fprintf(stderr, "kernel_launch: hipFuncSetAttribute failed\n"); grid = -1; return; }
        if (hipOccupancyMaxActiveBlocksPerMultiprocessor(&per_cu, (const void*)hybrid_fwd, 512, LDS_BYTES) != hipSuccess || per_cu < 1) { fprintf(stderr, "kernel_launch: occupancy query failed (%d)\n", per_cu); grid = -1; return; }
        grid = cus;
    }
    if (grid < 0) return;
    if (hipMemsetAsync((char*)d_ws + OFF_BAR, 0, 16384, stream) != hipSuccess) { fprintf(stderr, "kernel_launch: memset of barrier words failed\n"); return; }
    Args a{};
    for (int i = 0; i < 28; ++i) a.in[i] = (const float*)d_in[i];
    a.out = (float*)d_out; a.ws = (unsigned char*)d_ws; a.ph_lo = 0; a.ph_hi = NPHASE;
    void* args[] = {&a};
    hipError_t e = hipLaunchCooperativeKernel((const void*)hybrid_fwd, dim3(grid), dim3(512), args, LDS_BYTES, stream);
    if (e != hipSuccess) fprintf(stderr, "kernel_launch: cooperative launch failed: %s (grid %d)\n", hipGetErrorString(e), grid);
}
```

```cpp
#include <hip/hip_runtime.h>
#include <hip/hip_cooperative_groups.h>
#include <cstdio>
#include <cstdint>
namespace cg = cooperative_groups;

#define LAS __attribute__((address_space(3)))
typedef unsigned short bf16_t;
typedef short bf16x8 __attribute__((ext_vector_type(8)));
typedef float f32x4 __attribute__((ext_vector_type(4)));
typedef unsigned u32x4 __attribute__((ext_vector_type(4)));
typedef unsigned u32x2 __attribute__((ext_vector_type(2)));

constexpr int DM = 1024, NB = 8, SEQ = 2048, NMETA = 16, LP = SEQ + NMETA  , NS = 128;
constexpr int MP = NB * LP  , M = MP + NS  ;
constexpr int DFF = 2816, DSHIFT = 3328, DPROJ = 8448;
constexpr size_t O_YP = 0, O_YS = O_YP + (size_t)NB * SEQ * DM, O_WKVP = O_YS + (size_t)NS * DM, O_SHP = O_WKVP + 2ull * NB * 16 * 4096,
                 O_CVP = O_SHP + 2ull * NB * DSHIFT, O_WKVS = O_CVP + 2ull * NB * 2 * DM, O_SHS = O_WKVS + 2ull * NS * 16 * 4096,
                 O_CVS = O_SHS + 2ull * NS * DSHIFT, O_END = O_CVS + 2ull * NS * 2 * DM;
constexpr size_t SZ_W1 = 5632ull * 1024 * 2, SZ_W2 = 1024ull * 2816 * 2, SZ_WIN = 8448ull * 1024 * 2, SZ_WO = 1024ull * 1024 * 2, SZ_WL = 3072ull * 256 * 2;
constexpr size_t OFF_W1 = 0, OFF_W2 = OFF_W1 + SZ_W1, OFF_WIN = OFF_W2 + SZ_W2, OFF_WO = OFF_WIN + SZ_WIN, OFF_W5 = OFF_WO + SZ_WO, OFF_W6 = OFF_W5 + SZ_W1,
                 OFF_WL = OFF_W6 + SZ_W2, OFF_XLO = OFF_WL + 2 * SZ_WL, OFF_YRAW = OFF_XLO + (size_t)M * DM * 2, OFF_SS = OFF_YRAW + (size_t)M * DM * 2, OFF_BETA = OFF_SS + (size_t)M * 16 * 4,
                 OFF_L = OFF_BETA + (size_t)M * 16 * 4,
                 OFF_BIG = OFF_L + (size_t)M * 256 * 2;
constexpr size_t BLK = (size_t)M * DM * 2, SZ_PS = (size_t)M * DSHIFT * 2;
constexpr size_t OFF_PS = OFF_BIG, OFF_E = OFF_PS + SZ_PS, OFF_A = OFF_E + BLK, OFF_G = OFF_A + BLK, OFF_BAR = OFF_G + BLK, OFF_SA0 = OFF_BAR + 16384, WS_END = OFF_SA0 + (size_t)M * 256 * 2;
constexpr size_t OFF_H = OFF_BIG;
constexpr int LDS_RSTD = 131072 + 512;
constexpr int LDS_BYTES = LDS_RSTD + 8 * 256 * 4;
constexpr int NPHASE = 24;
#ifndef DUP_MASK
#define DUP_MASK 0
#endif

struct Args { const float* in[28]; float* out; unsigned char* ws; int ph_lo, ph_hi; };

typedef __bf16 bf16x2_t __attribute__((ext_vector_type(2)));
typedef float f32x2_t __attribute__((ext_vector_type(2)));
__device__ __forceinline__ unsigned pk2(float lo, float hi) { const f32x2_t v = {lo, hi}; const bf16x2_t b = __builtin_convertvector(v, bf16x2_t); return __builtin_bit_cast(unsigned, b); }
__device__ __forceinline__ float bflo(unsigned u) { return __uint_as_float(u << 16); }
__device__ __forceinline__ float bfhi(unsigned u) { return __uint_as_float(u & 0xffff0000u); }
__device__ __forceinline__ int otid() { int t = threadIdx.x; asm volatile("" : "+v"(t)); return t; }
__device__ __forceinline__ float sigm(float x) { return __builtin_amdgcn_rcpf(1.f + __expf(-x)); }
template <int CTRL> __device__ __forceinline__ float dppf(float x) { return __builtin_bit_cast(float, __builtin_amdgcn_mov_dpp(__builtin_bit_cast(int, x), CTRL, 0xf, 0xf, true)); }
__device__ __forceinline__ float red8(float x) { x += dppf<0xB1>(x); x += dppf<0x4E>(x); x += dppf<0x141>(x); return x; }
__device__ __forceinline__ float red16(float x) { x = red8(x); x += dppf<0x128>(x); return x; }
__device__ __forceinline__ float row_rstd(const float* SS, int row) {
    const f32x4* p = (const f32x4*)(SS + (size_t)row * 16);
    const f32x4 a = p[0], b = p[1], c = p[2], d = p[3];
    const float s = ((a[0] + a[1]) + (a[2] + a[3])) + ((b[0] + b[1]) + (b[2] + b[3])) + ((c[0] + c[1]) + (c[2] + c[3])) + ((d[0] + d[1]) + (d[2] + d[3]));
    return rsqrtf(s * (1.f / 1024.f) + 1e-6f);
}

namespace pg8 {
constexpr int BM = 256, BK = 64, HALF = 128, HTB = HALF * BK * 2, STAGE_BYTES = 8 * HTB, NXCD = 8, WGM = 8;
__host__ __device__ __forceinline__ int lds_byte(int r, int c) { const int st = (r >> 4) * 2 + (c >> 5), rr = r & 15, cc = c & 31, ob = rr * 64 + cc * 2; return st * 1024 + (ob ^ (((ob >> 9) & 1) << 5)); }
__host__ __device__ __forceinline__ void stage_rc(int b, int& R, int& C) { const int st = b / 1024, sb = b % 1024, swz = sb ^ (((sb >> 9) & 1) << 5); R = (st >> 1) * 16 + swz / 64; C = (st & 1) * 32 + (swz % 64) / 2; }
__host__ __device__ __forceinline__ int perm32(int rho) { const int n = rho >> 4, i = rho & 15; return 8 * (i >> 2) + 4 * n + (i & 3); }
struct Unit { int pm, pn; };
struct Gemm { const bf16_t* A; const bf16_t* Bt; int M, N, K, lda; };
struct StaticOrder {
    int nM, nN, nwg, G, c;
    __device__ void init(int M_, int N_, int G_, int c_) { nM = M_ / BM; nN = N_ / BM; nwg = nM * nN; G = G_; c = c_; }
    __device__ bool next(int i, Unit& u) const {
        const long L = (long)i * G + c; if (L >= nwg) return false;
        int wgid = (int)L; { const int q = nwg / NXCD, r = nwg % NXCD, xcd = wgid % NXCD, off = wgid / NXCD; wgid = (xcd < r ? xcd * (q + 1) : r * (q + 1) + (xcd - r) * q) + off; }
        const int nig = WGM * nN, gid = wgid / nig, fm = gid * WGM, gsz = (nM - fm) < WGM ? (nM - fm) : WGM;
        u.pm = fm + ((wgid % nig) % gsz); u.pn = (wgid % nig) / gsz; return true;
    }
};

template <class Epi>
__device__ __forceinline__ void gemm_phase(LAS unsigned char* lds, const Gemm g, const StaticOrder& S, const Epi& E) {
    const int tid = otid(), wid = __builtin_amdgcn_readfirstlane(tid >> 6), lane = tid & 63, wr = wid >> 2, wc = wid & 3, fr = lane & 15, fq = lane >> 4;
    int K = g.K, lda = g.lda; asm volatile("" : "+s"(K), "+s"(lda));
    const int nt = K / BK;
    unsigned voffA[2], voffB[2];
#pragma unroll
    for (int i = 0; i < 2; ++i) { int R, C; stage_rc(tid * 16 + i * 8192, R, C); const int Rb = Epi::PERM ? ((R & ~31) + perm32(R & 31)) : R;
        voffA[i] = (unsigned)(R * lda + C) * 2u; voffB[i] = (unsigned)(Rb * K + C) * 2u; }
    const size_t kstep = (size_t)(BK * 2);
    const size_t hstepA = (size_t)HALF * lda * 2, hstepB = (size_t)HALF * K * 2;
    const size_t tstepA = 2 * hstepA, tstepB = 2 * hstepB;
    const unsigned ldsw = (unsigned)wid * 1024u;
    const int aoff = lds_byte(wr * 64 + fr, fq * 8), boff = lds_byte(wc * 32 + fr, fq * 8);
#define PG8_SA(b, h) (((b) * 2 + (h)) * HTB)
#define PG8_SB(b, h) ((4 + (b) * 2 + (h)) * HTB)
#define PG8_STAGE(bufoff, gbase, voff) do { _Pragma("unroll") for (int _i = 0; _i < 2; ++_i) \
        __builtin_amdgcn_global_load_lds((const unsigned*)((const char*)(gbase) + (voff)[_i]), (LAS unsigned*)(lds + (bufoff) + ldsw + _i * 8192), 16, 0, 0); } while (0)
#define PG8_LDA(dst, b, h) do { _Pragma("unroll") for (int m = 0; m < 4; ++m) _Pragma("unroll") for (int k = 0; k < 2; ++k) dst[m][k] = *(const LAS bf16x8*)(lds + PG8_SA(b, h) + aoff + m * 2048 + k * 1024); } while (0)
#define PG8_LDB(dst, b, h) do { _Pragma("unroll") for (int n = 0; n < 2; ++n) _Pragma("unroll") for (int k = 0; k < 2; ++k) dst[n][k] = *(const LAS bf16x8*)(lds + PG8_SB(b, h) + boff + n * 2048 + k * 1024); } while (0)
#define PG8_MMA(ai, bj, At, Bt) do { __builtin_amdgcn_s_setprio(1); _Pragma("unroll") for (int m = 0; m < 4; ++m) _Pragma("unroll") for (int n = 0; n < 2; ++n) _Pragma("unroll") for (int k = 0; k < 2; ++k) \
        acc[ai][bj][m][n] = __builtin_amdgcn_mfma_f32_16x16x32_bf16(Bt[n][k], At[m][k], acc[ai][bj][m][n], 0, 0, 0); __builtin_amdgcn_s_setprio(0); } while (0)
#define PG8_WAIT_V(n) asm volatile("s_waitcnt vmcnt(" #n ")" ::: "memory")
#define PG8_WAIT_L(n) asm volatile("s_waitcnt lgkmcnt(" #n ")" ::: "memory")
#define PG8_BAR __builtin_amdgcn_s_barrier()
#define PG8_SCHED __builtin_amdgcn_sched_barrier(0)
    Unit cur, nxt; int ui = 0;
    if (!S.next(0, cur)) return;
    f32x4 acc[2][2][4][2];
#pragma unroll
    for (int a = 0; a < 2; ++a)
#pragma unroll
        for (int b = 0; b < 2; ++b)
#pragma unroll
            for (int m = 0; m < 4; ++m)
#pragma unroll
                for (int n = 0; n < 2; ++n) acc[a][b][m][n] = (f32x4){0.f, 0.f, 0.f, 0.f};
    bf16x8 At[4][2], B0[2][2], B1[2][2];
    const char* cA = (const char*)g.A + (size_t)cur.pm * tstepA; const char* cB = (const char*)g.Bt + (size_t)cur.pn * tstepB;
    PG8_STAGE(PG8_SB(0, 0), cB, voffB); PG8_STAGE(PG8_SB(0, 1), cB + hstepB, voffB); PG8_STAGE(PG8_SA(0, 0), cA, voffA); PG8_STAGE(PG8_SA(0, 1), cA + hstepA, voffA);
    if (wr == 1) PG8_BAR;
    PG8_WAIT_V(2); PG8_BAR;
    PG8_STAGE(PG8_SB(1, 0), cB + kstep, voffB); PG8_STAGE(PG8_SA(1, 0), cA + kstep, voffA); PG8_STAGE(PG8_SB(1, 1), cB + hstepB + kstep, voffB);
    PG8_WAIT_V(6); PG8_BAR;
    for (;;) {
        const bool has_next = S.next(ui + 1, nxt);
        const char* nA = has_next ? (const char*)g.A + (size_t)nxt.pm * tstepA : cA; const char* nB = has_next ? (const char*)g.Bt + (size_t)nxt.pn * tstepB : cB;
        for (int t = 0; t < nt; t += 2) {
            const bool last = (t == nt - 2);
            const char* a1 = cA + (size_t)(t + 1) * kstep;
            const char* a2 = last ? nA : cA + (size_t)(t + 2) * kstep; const char* b2 = last ? nB : cB + (size_t)(t + 2) * kstep;
            const char* a3 = a2 + kstep; const char* b3 = b2 + kstep;
            PG8_LDB(B0, 0, 0); PG8_LDB(B1, 0, 1); PG8_SCHED; PG8_LDA(At, 0, 0); PG8_STAGE(PG8_SA(1, 1), a1 + hstepA, voffA);
            PG8_WAIT_V(8); PG8_WAIT_L(0); PG8_BAR; PG8_MMA(0, 0, At, B0); PG8_MMA(0, 1, At, B1); PG8_BAR; PG8_SCHED;
            PG8_LDA(At, 0, 1); PG8_STAGE(PG8_SB(0, 0), b2, voffB); PG8_STAGE(PG8_SB(0, 1), b2 + hstepB, voffB); PG8_STAGE(PG8_SA(0, 0), a2, voffA);
            PG8_WAIT_V(8); PG8_WAIT_L(0); PG8_BAR; PG8_MMA(1, 0, At, B0); PG8_MMA(1, 1, At, B1); PG8_BAR; PG8_SCHED;
            PG8_LDB(B0, 1, 0); PG8_LDB(B1, 1, 1); PG8_SCHED; PG8_LDA(At, 1, 0); PG8_STAGE(PG8_SA(0, 1), a2 + hstepA, voffA);
            PG8_WAIT_V(8); PG8_WAIT_L(0); PG8_BAR; PG8_MMA(0, 0, At, B0); PG8_MMA(0, 1, At, B1); PG8_BAR; PG8_SCHED;
            PG8_LDA(At, 1, 1); PG8_STAGE(PG8_SB(1, 0), b3, voffB); PG8_STAGE(PG8_SB(1, 1), b3 + hstepB, voffB); PG8_STAGE(PG8_SA(1, 0), a3, voffA);
            PG8_WAIT_V(8); PG8_WAIT_L(0); PG8_BAR; PG8_MMA(1, 0, At, B0); PG8_MMA(1, 1, At, B1); PG8_BAR; PG8_SCHED;
        }
        if (wr == 0) PG8_BAR;
        E(acc, cur, wr, wc, fr, fq, ui);
        if (!has_next) break;
#pragma unroll
        for (int a = 0; a < 2; ++a)
#pragma unroll
            for (int b = 0; b < 2; ++b)
#pragma unroll
                for (int m = 0; m < 4; ++m)
#pragma unroll
                    for (int n = 0; n < 2; ++n) acc[a][b][m][n] = (f32x4){0.f, 0.f, 0.f, 0.f};
        cur = nxt; cA = nA; cB = nB; ++ui;
        if (wr == 1) PG8_BAR;
    }
    PG8_WAIT_V(0);
    PG8_BAR;
#undef PG8_SA
#undef PG8_SB
#undef PG8_STAGE
#undef PG8_LDA
#undef PG8_LDB
#undef PG8_MMA
#undef PG8_WAIT_V
#undef PG8_WAIT_L
#undef PG8_BAR
#undef PG8_SCHED
}
}

__device__ __forceinline__ void prep_rstd(LAS float* tab, const float* SS, const pg8::StaticOrder& S) {
    const int tid = otid(), r = tid >> 1, h = tid & 1;
#pragma unroll 1
    for (int i0 = 0; i0 < 8; i0 += 4) {
        f32x4 p0[4], p1[4]; bool ok[4];
#pragma unroll
        for (int q = 0; q < 4; ++q) { pg8::Unit u; ok[q] = S.next(i0 + q, u);
            if (ok[q]) { const float* sp = SS + (size_t)(u.pm * 256 + r) * 16 + h * 8; p0[q] = *(const f32x4*)sp; p1[q] = *(const f32x4*)(sp + 4); } }
#pragma unroll
        for (int q = 0; q < 4; ++q) if (ok[q]) {
            float s = ((p0[q][0] + p0[q][1]) + (p0[q][2] + p0[q][3])) + ((p1[q][0] + p1[q][1]) + (p1[q][2] + p1[q][3]));
            s += dppf<0xB1>(s);
            if (h == 0) tab[(i0 + q) * 256 + r] = rsqrtf(s * (1.f / 1024.f) + 1e-6f);
        }
    }
    __syncthreads();
}
__device__ __forceinline__ void rows_rstd(const LAS float* tab, int ui, int wr, int fr, float (&rs)[2][4]) {
#pragma unroll
    for (int ai = 0; ai < 2; ++ai)
#pragma unroll
        for (int m = 0; m < 4; ++m) rs[ai][m] = tab[(ui & 7) * 256 + ai * 128 + wr * 64 + m * 16 + fr];
}


typedef const f32x4 (&AccRef)[2][2][4][2];

struct EpiFfnIn {
    static constexpr bool PERM = true;
    const LAS float* RT; bf16_t* H;
    __device__ __forceinline__ void operator()(AccRef acc, const pg8::Unit& u, int wr, int wc, int fr, int fq, int ui) const {
        const int row0 = u.pm * 256 + wr * 64 + fr, col0 = u.pn * 128 + wc * 32 + fq * 8;
        float rsv[2][4]; rows_rstd(RT, ui, wr, fr, rsv);
#pragma unroll
        for (int ai = 0; ai < 2; ++ai)
#pragma unroll
            for (int m = 0; m < 4; ++m) {
                __builtin_amdgcn_sched_barrier(0); const int row = row0 + ai * 128 + m * 16; const float rs = rsv[ai][m];
                u32x4 w;
#pragma unroll
                for (int n = 0; n < 2; ++n) {
                    const f32x4 gt = acc[ai][0][m][n] * rs, up = acc[ai][1][m][n] * rs; float h[4];
#pragma unroll
                    for (int i = 0; i < 4; ++i) h[i] = gt[i] * sigm(gt[i]) * up[i];
                    w[2 * n] = pk2(h[0], h[1]); w[2 * n + 1] = pk2(h[2], h[3]);
                }
                *(u32x4*)(H + (size_t)row * DFF + col0) = w;
            }
    }
};

struct EpiRes {
    static constexpr bool PERM = true;
    const bf16_t* XB; bf16_t* XBo; float* SS; float scale;
    __device__ __forceinline__ void operator()(AccRef acc, const pg8::Unit& u, int wr, int wc, int fr, int fq, int ui) const {
        const int row0 = u.pm * 256 + wr * 64 + fr, col0 = u.pn * 256 + wc * 32 + fq * 8;
        u32x4 hi[2][4][2];
#pragma unroll
        for (int ai = 0; ai < 2; ++ai)
#pragma unroll
            for (int m = 0; m < 4; ++m)
#pragma unroll
                for (int bj = 0; bj < 2; ++bj) hi[ai][m][bj] = *(const u32x4*)(XB + (size_t)(row0 + ai * 128 + m * 16) * DM + col0 + bj * 128);
#pragma unroll
        for (int ai = 0; ai < 2; ++ai)
#pragma unroll
            for (int m = 0; m < 4; ++m) {
                __builtin_amdgcn_sched_barrier(0);
                const int row = row0 + ai * 128 + m * 16; float ss = 0.f;
#pragma unroll
                for (int bj = 0; bj < 2; ++bj) {
                    const size_t o = (size_t)row * DM + col0 + bj * 128;
                    float x[8];
#pragma unroll
                    for (int i = 0; i < 4; ++i) { x[2 * i] = bflo(hi[ai][m][bj][i]) + acc[ai][bj][m][i >> 1][(i & 1) * 2] * scale; x[2 * i + 1] = bfhi(hi[ai][m][bj][i]) + acc[ai][bj][m][i >> 1][(i & 1) * 2 + 1] * scale; }
                    u32x4 wh;
#pragma unroll
                    for (int i = 0; i < 4; ++i) { wh[i] = pk2(x[2 * i], x[2 * i + 1]); ss += x[2 * i] * x[2 * i] + x[2 * i + 1] * x[2 * i + 1]; }
                    *(u32x4*)(XBo + o) = wh;
                }
                ss += __shfl_xor(ss, 16); ss += __shfl_xor(ss, 32);
                if (fq == 0) SS[(size_t)row * 16 + u.pn * 4 + wc] = ss;
            }
    }
};

struct EpiPS {
    static constexpr bool PERM = true;
    const LAS float* RT; bf16_t* PS; float* shp; float* shs; bf16_t* SA0;
    __device__ __forceinline__ void operator()(AccRef acc, const pg8::Unit& u, int wr, int wc, int fr, int fq, int ui) const {
        const int row0 = u.pm * 256 + wr * 64 + fr, col0 = u.pn * 256 + wc * 32 + fq * 8;
        float rsv[2][4]; rows_rstd(RT, ui, wr, fr, rsv);
        if (u.pn == 13) {
#pragma unroll
            for (int ai = 0; ai < 2; ++ai)
#pragma unroll
                for (int m = 0; m < 4; ++m) {
                    __builtin_amdgcn_sched_barrier(0); const int row = row0 + ai * 128 + m * 16; const float rs = rsv[ai][m];
#pragma unroll
                    for (int bj = 0; bj < 2; ++bj) {
                        const f32x4 v0 = acc[ai][bj][m][0] * rs, v1 = acc[ai][bj][m][1] * rs;
                        u32x4 w; w[0] = pk2(sigm(v0[0]), sigm(v0[1])); w[1] = pk2(sigm(v0[2]), sigm(v0[3])); w[2] = pk2(sigm(v1[0]), sigm(v1[1])); w[3] = pk2(sigm(v1[2]), sigm(v1[3]));
                        *(u32x4*)(SA0 + (size_t)row * 256 + bj * 128 + wc * 32 + fq * 8) = w;
                    }
                }
            return;
        }
#pragma unroll
        for (int ai = 0; ai < 2; ++ai)
#pragma unroll
            for (int m = 0; m < 4; ++m) {
                __builtin_amdgcn_sched_barrier(0); const int row = row0 + ai * 128 + m * 16; const float rs = rsv[ai][m];
                float* sd = nullptr;
                if (row >= MP) sd = shs + (size_t)(row - MP) * DSHIFT; else { const int b = row / LP; if (row - b * LP == LP - 1) sd = shp + (size_t)b * DSHIFT; }
#pragma unroll
                for (int bj = 0; bj < 2; ++bj) {
                    const int col = col0 + bj * 128;
                    const f32x4 v0 = acc[ai][bj][m][0] * rs, v1 = acc[ai][bj][m][1] * rs;
                    u32x4 w; w[0] = pk2(v0[0], v0[1]); w[1] = pk2(v0[2], v0[3]); w[2] = pk2(v1[0], v1[1]); w[3] = pk2(v1[2], v1[3]);
                    *(u32x4*)(PS + (size_t)row * DSHIFT + col) = w;
                    if (sd) { *(f32x4*)(sd + col) = v0; *(f32x4*)(sd + col + 4) = v1; }
                }
            }
    }
};

struct EpiCG {
    static constexpr bool PERM = true;
    const LAS float* RT; bf16_t *SAb, *Qb, *Ub; float* cvp; float* cvs; const float* conv0;
    __device__ __forceinline__ void operator()(AccRef acc, const pg8::Unit& u, int wr, int wc, int fr, int fq, int ui) const {
        const int row0 = u.pm * 256 + wr * 64 + fr, cw = wc * 32 + fq * 8;
        float rsv[2][4]; rows_rstd(RT, ui, wr, fr, rsv);
        const int pn = u.pn + 1;
        if (pn < 4) {
#pragma unroll
            for (int ai = 0; ai < 2; ++ai)
#pragma unroll
                for (int m = 0; m < 4; ++m) {
                    __builtin_amdgcn_sched_barrier(0); const int row = row0 + ai * 128 + m * 16; const float rs = rsv[ai][m];
#pragma unroll
                    for (int bj = 0; bj < 2; ++bj) {
                        const f32x4 v0 = acc[ai][bj][m][0] * rs, v1 = acc[ai][bj][m][1] * rs;
                        u32x4 w; w[0] = pk2(sigm(v0[0]), sigm(v0[1])); w[1] = pk2(sigm(v0[2]), sigm(v0[3])); w[2] = pk2(sigm(v1[0]), sigm(v1[1])); w[3] = pk2(sigm(v1[2]), sigm(v1[3]));
                        *(u32x4*)(SAb + (size_t)row * DM + pn * 256 + bj * 128 + cw) = w;
                    }
                }
        } else if (pn < 12) {
            const int col = (pn - 4) * 128 + cw;
#pragma unroll
            for (int ai = 0; ai < 2; ++ai)
#pragma unroll
                for (int m = 0; m < 4; ++m) {
                    __builtin_amdgcn_sched_barrier(0); const int row = row0 + ai * 128 + m * 16; const float rs = rsv[ai][m];
                    u32x4 w;
#pragma unroll
                    for (int n = 0; n < 2; ++n) {
                        const f32x4 a = acc[ai][0][m][n] * rs, b = acc[ai][1][m][n] * rs;
                        w[2 * n] = pk2(sigm(a[0]) * b[0], sigm(a[1]) * b[1]); w[2 * n + 1] = pk2(sigm(a[2]) * b[2], sigm(a[3]) * b[3]);
                    }
                    *(u32x4*)(Qb + (size_t)row * DM + col) = w;
                }
        } else {
            const int col = (pn - 12) * 128 + cw;
#pragma unroll
            for (int ai = 0; ai < 2; ++ai)
#pragma unroll
                for (int m = 0; m < 4; ++m) {
                    __builtin_amdgcn_sched_barrier(0); const int row = row0 + ai * 128 + m * 16; const float rs = rsv[ai][m];
                    const f32x4 u0 = (acc[ai][0][m][0] * rs) * (acc[ai][1][m][0] * rs), u1 = (acc[ai][0][m][1] * rs) * (acc[ai][1][m][1] * rs);
                    u32x4 w; w[0] = pk2(u0[0], u0[1]); w[1] = pk2(u0[2], u0[3]); w[2] = pk2(u1[0], u1[1]); w[3] = pk2(u1[2], u1[3]);
                    *(u32x4*)(Ub + (size_t)row * DSHIFT + col) = w;
                    float* cd = nullptr;
                    if (row >= MP) {
                        const int s = row - MP; cd = cvs + (size_t)(s * 2 + 1) * DM + col;
                        const float* cs = conv0 + (size_t)(s * 2 + 1) * DM + col; float* c0 = cvs + (size_t)(s * 2) * DM + col;
                        *(f32x4*)c0 = *(const f32x4*)cs; *(f32x4*)(c0 + 4) = *(const f32x4*)(cs + 4);
                    } else { const int b = row / LP, t = row - b * LP; if (t >= LP - 2) cd = cvp + (size_t)(b * 2 + (t - (LP - 2))) * DM + col; }
                    if (cd) { *(f32x4*)cd = u0; *(f32x4*)(cd + 4) = u1; }
                }
        }
    }
};

struct EpiLora {
    static constexpr bool PERM = true;
    bf16_t *E, *A, *G; const float* w0; const float* a0;
    template <int SEC> __device__ __forceinline__ void run(AccRef acc, bf16_t* dst, const float* bias, int row0, int cb) const {
#pragma unroll
        for (int bj = 0; bj < 2; ++bj) {
            const int col = cb + bj * 128;
            f32x4 b0 = (f32x4){0.f, 0.f, 0.f, 0.f}, b1 = b0;
            if (SEC < 2) { b0 = *(const f32x4*)(bias + col); b1 = *(const f32x4*)(bias + col + 4); }
#pragma unroll
            for (int ai = 0; ai < 2; ++ai)
#pragma unroll
                for (int m = 0; m < 4; ++m) {
                    __builtin_amdgcn_sched_barrier(0); const int row = row0 + ai * 128 + m * 16;
                    const f32x4 v0 = acc[ai][bj][m][0] + b0, v1 = acc[ai][bj][m][1] + b1;
                    u32x4 w;
                    if (SEC == 0) { const float sc = -0.60653065971f;
                        w[0] = pk2(sc * sigm(v0[0]), sc * sigm(v0[1])); w[1] = pk2(sc * sigm(v0[2]), sc * sigm(v0[3])); w[2] = pk2(sc * sigm(v1[0]), sc * sigm(v1[1])); w[3] = pk2(sc * sigm(v1[2]), sc * sigm(v1[3])); }
                    else if (SEC == 1) { w[0] = pk2(sigm(v0[0]), sigm(v0[1])); w[1] = pk2(sigm(v0[2]), sigm(v0[3])); w[2] = pk2(sigm(v1[0]), sigm(v1[1])); w[3] = pk2(sigm(v1[2]), sigm(v1[3])); }
                    else { w[0] = pk2(v0[0], v0[1]); w[1] = pk2(v0[2], v0[3]); w[2] = pk2(v1[0], v1[1]); w[3] = pk2(v1[2], v1[3]); }
                    *(u32x4*)(dst + (size_t)row * DM + col) = w;
                }
        }
    }
    __device__ __forceinline__ void operator()(AccRef acc, const pg8::Unit& u, int wr, int wc, int fr, int fq, int ui) const {
        const int row0 = u.pm * 256 + wr * 64 + fr, sec = u.pn >> 2, cb = (u.pn & 3) * 256 + wc * 32 + fq * 8;
        if (sec == 0) run<0>(acc, E, w0, row0, cb); else if (sec == 1) run<1>(acc, A, a0, row0, cb); else run<2>(acc, G, nullptr, row0, cb);
    }
};

__device__ __forceinline__ int colmap(int MAP, int n) {
    if (MAP == 0) return n;
    if (MAP == 1) { const int pn = n >> 8, w = n & 255, hh = pn * 128 + (w & 127); return (w & 128) ? DFF + hh : hh; }
    if (n < DSHIFT) return n;
    const int np = n - DSHIFT, pn = np >> 8, w = np & 255, j = w & 127, bj = w >> 7;
    if (pn < 4) return 6400 + pn * 256 + w;
    if (pn < 12) { const int ch = (pn - 4) * 128 + j; return bj ? 3328 + ch : 7424 + ch; }
    const int ch = (pn - 12) * 128 + j; return bj ? 5376 + ch : 4352 + ch;
}
__device__ __forceinline__ void conv_weight(LAS float* tile, const float* src, int ldsrc, bf16_t* dst, int N, int K, const float* scale, int MAP, int first, int stride) {
    const int tid = otid(), kt_n = K >> 6, items = (N >> 6) * kt_n;
    f32x4 R[4][2];
#define CW_LOAD(it_) do { _Pragma("unroll") for (int q = 0; q < 4; ++q) { const int itq = (it_) + q * stride; \
        if (itq < items) { const int n0 = (itq / kt_n) << 6, k0 = (itq % kt_n) << 6, c0 = colmap(MAP, n0); \
            _Pragma("unroll") for (int i = 0; i < 2; ++i) { const int f = tid + 512 * i, k = f >> 4, n4 = (f & 15) << 2; \
                R[q][i] = *(const f32x4*)(src + (size_t)(k0 + k) * ldsrc + c0 + n4); } } } } while (0)
    if (first < items) CW_LOAD(first);
    for (int it = first; it < items; it += 4 * stride) {
#pragma unroll
        for (int q = 0; q < 4; ++q) {
            const int itq = it + q * stride;
            if (itq < items) {
                const int k0 = (itq % kt_n) << 6;
#pragma unroll
                for (int i = 0; i < 2; ++i) {
                    const int f = tid + 512 * i, k = f >> 4, n4 = (f & 15) << 2;
                    f32x4 v = R[q][i];
                    if (scale) v *= scale[k0 + k];
                    LAS float* tp = tile + q * 4160 + k * 65 + n4; tp[0] = v[0]; tp[1] = v[1]; tp[2] = v[2]; tp[3] = v[3];
                }
            }
        }
        if (it + 4 * stride < items) CW_LOAD(it + 4 * stride);
        __syncthreads();
#pragma unroll
        for (int q = 0; q < 4; ++q) {
            const int itq = it + q * stride;
            if (itq < items) {
                const int n0 = (itq / kt_n) << 6, k0 = (itq % kt_n) << 6;
                const int n = tid >> 3, kg = (tid & 7) << 3; const LAS float* tp = tile + q * 4160 + kg * 65 + n;
                u32x4 w; w[0] = pk2(tp[0], tp[65]); w[1] = pk2(tp[130], tp[195]); w[2] = pk2(tp[260], tp[325]); w[3] = pk2(tp[390], tp[455]);
                *(u32x4*)(dst + (size_t)(n0 + n) * K + k0 + kg) = w;
            }
        }
        __syncthreads();
    }
#undef CW_LOAD
}
__device__ __forceinline__ void conv_jobs(const Args& a, LAS float* tile, unsigned jobs, int first, int stride) {
    unsigned char* ws = a.ws;
    for (int jb = 0; jb < 12; ++jb) {
        if (!((jobs >> jb) & 1u)) continue;
        const int l = jb / 6, w = jb - l * 6;
        const float* src; const float* scale = nullptr; bf16_t* dst; int ldsrc, N, K, MAP = 0;
        if (w == 0 || w == 4) { src = a.in[w == 0 ? 7 : 25] + (size_t)l * DM * 2 * DFF; ldsrc = 2 * DFF; dst = (bf16_t*)(ws + (w == 0 ? OFF_W1 : OFF_W5)); N = 2 * DFF; K = DM; scale = a.in[w == 0 ? 6 : 24] + l * DM; MAP = 1; }
        else if (w == 1 || w == 5) { src = a.in[w == 1 ? 8 : 26] + (size_t)l * DFF * DM; ldsrc = DM; dst = (bf16_t*)(ws + (w == 1 ? OFF_W2 : OFF_W6)); N = DM; K = DFF; }
        else if (w == 2) { src = a.in[10] + (size_t)l * DM * DPROJ; ldsrc = DPROJ; dst = (bf16_t*)(ws + OFF_WIN); N = DPROJ; K = DM; scale = a.in[9] + l * DM; MAP = 2; }
        else { src = a.in[23] + (size_t)l * DM * DM; ldsrc = DM; dst = (bf16_t*)(ws + OFF_WO); N = DM; K = DM; }
        conv_weight(tile, src, ldsrc, dst, N, K, scale, MAP, first, stride);
    }
}

__device__ __forceinline__ void phase_prologue(const Args& a, LAS float* ldsf) {
    unsigned char* ws = a.ws;
    const int tid = otid(), lane = tid & 63, wid = tid >> 6;
    { bf16_t* XB = (bf16_t*)a.out; float* SS = (float*)(ws + OFF_SS);
      for (int row = blockIdx.x * 8 + wid; row < M; row += gridDim.x * 8) {
          const float* src;
          if (row >= MP) src = a.in[1] + (size_t)(row - MP) * DM;
          else { const int b = row / LP, t = row - b * LP; src = t < NMETA ? a.in[5] + (size_t)t * DM : a.in[0] + ((size_t)b * SEQ + (t - NMETA)) * DM; }
          float ss = 0.f;
#pragma unroll
          for (int i = 0; i < 4; ++i) {
              const int c = lane * 4 + i * 256; const f32x4 v = *(const f32x4*)(src + c);
              u32x2 w; w[0] = pk2(v[0], v[1]); w[1] = pk2(v[2], v[3]); *(u32x2*)(XB + (size_t)row * DM + c) = w;
              ss += (v[0] * v[0] + v[1] * v[1]) + (v[2] * v[2] + v[3] * v[3]);
          }
#pragma unroll
          for (int o = 1; o < 64; o <<= 1) ss += __shfl_xor(ss, o);
          if (lane < 16) SS[(size_t)row * 16 + lane] = lane == 0 ? ss : 0.f;
      } }
    { bf16_t* WL = (bf16_t*)(ws + OFF_WL); const int total = 2 * 32 * 3072;
      for (int i = blockIdx.x * 512 + tid; i < total; i += gridDim.x * 512) {
          const int l = i / (32 * 3072), r = i - l * (32 * 3072), kg = r / 3072, n = r - kg * 3072, sec = n >> 10, ch = n & 1023, k0 = kg * 8;
          float v[8];
#pragma unroll
          for (int jx = 0; jx < 8; ++jx) v[jx] = 0.f;
          if (sec == 0) { if (k0 < 64) {
#pragma unroll
              for (int jx = 0; jx < 8; ++jx) v[jx] = a.in[13][((size_t)l * 64 + k0 + jx) * DM + ch]; } }
          else if (sec == 1) { if (k0 >= 64 && k0 < 128) {
#pragma unroll
              for (int jx = 0; jx < 8; ++jx) v[jx] = a.in[15][((size_t)l * 64 + (k0 - 64) + jx) * DM + ch]; } }
          else { if (k0 >= 128) {
#pragma unroll
              for (int jx = 0; jx < 8; ++jx) v[jx] = a.in[16][((size_t)l * 128 + (k0 - 128) + jx) * DM + ch]; } }
          u32x4 w; w[0] = pk2(v[0], v[1]); w[1] = pk2(v[2], v[3]); w[2] = pk2(v[4], v[5]); w[3] = pk2(v[6], v[7]);
          *(u32x4*)(WL + ((size_t)l * 3072 + n) * 256 + k0) = w;
      } }
}

__device__ __forceinline__ void phase_lbuild(const Args& a, int l) {
    unsigned char* ws = a.ws; const bf16_t* PS = (const bf16_t*)(ws + OFF_PS); bf16_t* L = (bf16_t*)(ws + OFF_L);
    const float* mu = a.in[11] + (size_t)l * DSHIFT + 3072; const float* sh0 = a.in[3] + (size_t)l * NS * DSHIFT;
    const int tid = otid(), jj = tid & 31, j0 = jj * 8;
    const f32x4 m0 = *(const f32x4*)(mu + j0), m1 = *(const f32x4*)(mu + j0 + 4);
    struct LIn { u32x4 cur, pv; f32x4 s0, s1; };
    auto lb_load = [&](int it, LIn& r) {
        const int row = it >> 5;
        r.cur = *(const u32x4*)(PS + (size_t)row * DSHIFT + 3072 + j0); r.pv = (u32x4){0u, 0u, 0u, 0u};
        if (row >= MP) { const float* sp = sh0 + (size_t)(row - MP) * DSHIFT + 3072 + j0; r.s0 = *(const f32x4*)sp; r.s1 = *(const f32x4*)(sp + 4); }
        else { const int b = row / LP, t = row - b * LP; if (t > 0) r.pv = *(const u32x4*)(PS + (size_t)(row - 1) * DSHIFT + 3072 + j0); }
    };
    auto lb_compute = [&](int it, const LIn& r) {
        const int row = it >> 5;
        float c[8], p[8];
#pragma unroll
        for (int i = 0; i < 4; ++i) { c[2 * i] = bflo(r.cur[i]); c[2 * i + 1] = bfhi(r.cur[i]); }
        if (row >= MP) {
#pragma unroll
            for (int i = 0; i < 4; ++i) { p[i] = r.s0[i]; p[4 + i] = r.s1[i]; }
        } else {
#pragma unroll
            for (int i = 0; i < 4; ++i) { p[2 * i] = bflo(r.pv[i]); p[2 * i + 1] = bfhi(r.pv[i]); }
        }
        float o[8];
#pragma unroll
        for (int i = 0; i < 8; ++i) {
            const float mm = i < 4 ? m0[i & 3] : m1[i & 3]; const float xs = c[i] + (p[i] - c[i]) * mm;
            o[i] = jj < 8 ? (1.f - 2.f * __builtin_amdgcn_rcpf(1.f + __expf(2.f * xs))) : (jj < 16 ? xs : sigm(xs));
        }
        u32x4 w; w[0] = pk2(o[0], o[1]); w[1] = pk2(o[2], o[3]); w[2] = pk2(o[4], o[5]); w[3] = pk2(o[6], o[7]);
        *(u32x4*)(L + (size_t)row * 256 + j0) = w;
    };
    const int step = gridDim.x * 512, total = M * 32;
    for (int it = blockIdx.x * 512 + tid; it < total; it += 2 * step) {
        LIn A, B; const bool hasB = it + step < total;
        lb_load(it, A); if (hasB) lb_load(it + step, B);
        lb_compute(it, A); if (hasB) lb_compute(it + step, B);
    }
}

typedef float f32x2 __attribute__((ext_vector_type(2)));
__device__ __forceinline__ void scan_prompt(const Args& a, LAS float* lds, int l, int b, int h, int half) {
    unsigned char* ws = a.ws;
#define SCAN_BAR() asm volatile("s_waitcnt lgkmcnt(0)\n\ts_barrier" ::: "memory")
    const bf16_t* PS = (const bf16_t*)(ws + OFF_PS); const bf16_t* Eb = (const bf16_t*)(ws + OFF_E); const bf16_t* Ab = (const bf16_t*)(ws + OFF_A);
    bf16_t* YR = (bf16_t*)(ws + OFF_YRAW); float* BETA = (float*)(ws + OFF_BETA);
    LAS float* vec = lds; LAS float* ybuf = lds + 2 * 12288; LAS float* beta = ybuf + 2 * 1024; LAS float* scal = beta + 64;
    const int tid = otid(), lane = tid & 63, wid = __builtin_amdgcn_readfirstlane(tid >> 6);
    const size_t rowbase = (size_t)b * LP;
    constexpr int nchunk = (LP + 31) / 32;
    if (wid < 4) {
        const int cg8 = (lane & 7) * 8, rloc = wid * 8 + (lane >> 3), vrow = half * 32 + rloc;
        f32x2 S[4];
#pragma unroll
        for (int j = 0; j < 4; ++j) S[j] = (f32x2){0.f, 0.f};
        SCAN_BAR();
        for (int c = 0; c < nchunk; ++c) {
            const LAS float* vb = vec + (c & 1) * 12288; LAS float* yb = ybuf + (c & 1) * 1024; const LAS float* scb = scal + (c & 1) * 64;
            const int nst = (LP - c * 32) < 32 ? (LP - c * 32) : 32;
#define SV_LOAD(P, s_) do { const LAS float* vp = tp + (s_) * 384;     \
                P##r0 = *(const LAS f32x4*)(vp); P##r1 = *(const LAS f32x4*)(vp + 4); P##w0 = *(const LAS f32x4*)(vp + 64); P##w1 = *(const LAS f32x4*)(vp + 68); \
                P##k0 = *(const LAS f32x4*)(vp + 128); P##k1 = *(const LAS f32x4*)(vp + 132); P##a0 = *(const LAS f32x4*)(vp + 192); P##a1 = *(const LAS f32x4*)(vp + 196); \
                P##b0 = *(const LAS f32x4*)(vp + 256); P##b1 = *(const LAS f32x4*)(vp + 260); P##vv = tv[(s_) * 384]; P##sc = *(const LAS f32x2*)(ts + 2 * (s_)); } while (0)
#define SV_STEP(P, s_) do { \
                const f32x2 rv[4] = {(f32x2){P##r0[0], P##r0[1]}, (f32x2){P##r0[2], P##r0[3]}, (f32x2){P##r1[0], P##r1[1]}, (f32x2){P##r1[2], P##r1[3]}}; \
                const f32x2 wv[4] = {(f32x2){P##w0[0], P##w0[1]}, (f32x2){P##w0[2], P##w0[3]}, (f32x2){P##w1[0], P##w1[1]}, (f32x2){P##w1[2], P##w1[3]}}; \
                const f32x2 kv[4] = {(f32x2){P##k0[0], P##k0[1]}, (f32x2){P##k0[2], P##k0[3]}, (f32x2){P##k1[0], P##k1[1]}, (f32x2){P##k1[2], P##k1[3]}}; \
                const f32x2 av[4] = {(f32x2){P##a0[0], P##a0[1]}, (f32x2){P##a0[2], P##a0[3]}, (f32x2){P##a1[0], P##a1[1]}, (f32x2){P##a1[2], P##a1[3]}}; \
                const f32x2 bv[4] = {(f32x2){P##b0[0], P##b0[1]}, (f32x2){P##b0[2], P##b0[3]}, (f32x2){P##b1[0], P##b1[1]}, (f32x2){P##b1[2], P##b1[3]}}; \
                  \
                f32x2 p = S[0] * av[0], q = S[0] * rv[0]; p = S[1] * av[1] + p; q = S[1] * rv[1] + q; p = S[2] * av[2] + p; q = S[2] * rv[2] + q; p = S[3] * av[3] + p; q = S[3] * rv[3] + q; \
                float sa = p[0] + p[1], yq = q[0] + q[1]; \
                sa += dppf<0xB1>(sa); yq += dppf<0xB1>(yq); sa += dppf<0x4E>(sa); yq += dppf<0x4E>(yq); sa += dppf<0x141>(sa); yq += dppf<0x141>(yq); \
                const f32x2 sa2 = (f32x2){sa, sa}, v2 = (f32x2){P##vv, P##vv}; \
                _Pragma("unroll") for (int j = 0; j < 4; ++j) S[j] = S[j] * wv[j] + (sa2 * bv[j] + v2 * kv[j]); \
                ty[(s_) * 32] = yq + sa * P##sc[0] + P##vv * P##sc[1]; } while (0)
            f32x4 Ar0, Ar1, Aw0, Aw1, Ak0, Ak1, Aa0, Aa1, Ab0, Ab1, Br0, Br1, Bw0, Bw1, Bk0, Bk1, Ba0, Ba1, Bb0, Bb1; float Avv, Bvv; f32x2 Asc, Bsc;
            const LAS float* tp = vb + cg8; const LAS float* tv = vb + 320 + vrow; const LAS float* ts = scb; LAS float* ty = yb + rloc;
            SV_LOAD(A, 0);
            for (int s = 0; s < nst; s += 8) {
                SV_LOAD(B, 1); SV_STEP(A, 0);
                SV_LOAD(A, 2); SV_STEP(B, 1);
                SV_LOAD(B, 3); SV_STEP(A, 2);
                SV_LOAD(A, 4); SV_STEP(B, 3);
                SV_LOAD(B, 5); SV_STEP(A, 4);
                SV_LOAD(A, 6); SV_STEP(B, 5);
                SV_LOAD(B, 7); SV_STEP(A, 6);
                if (s + 8 < nst) SV_LOAD(A, 8);
                SV_STEP(B, 7);
                tp += 8 * 384; tv += 8 * 384; ts += 16; ty += 8 * 32;
            }
#undef SV_LOAD
#undef SV_STEP
            SCAN_BAR();
        }
        { float* dst = a.out + O_WKVP + ((((size_t)l * NB + b) * 16 + h) * 64 + vrow) * 64 + cg8;
          *(f32x4*)dst = (f32x4){S[0][0], S[0][1], S[1][0], S[1][1]}; *(f32x4*)(dst + 4) = (f32x4){S[2][0], S[2][1], S[3][0], S[3][1]}; }
    } else {
        const int ht = tid - 256, tq = ht >> 4, c4 = (ht & 15) * 4, col = h * 64 + c4;
        const float* mus = a.in[11] + (size_t)l * DSHIFT;
        const f32x4 mu_r = *(const f32x4*)(mus + col), mu_k = *(const f32x4*)(mus + 1024 + col), mu_v = *(const f32x4*)(mus + 2048 + col);
        const f32x4 kkc = *(const f32x4*)(a.in[17] + l * DM + col), kac = *(const f32x4*)(a.in[18] + l * DM + col), rkc = *(const f32x4*)(a.in[19] + l * DM + col);
        const u32x2 z2 = (u32x2){0u, 0u};
        u32x2 RG[2][8];
#pragma unroll
        for (int p_ = 0; p_ < 2; ++p_)
#pragma unroll
            for (int q_ = 0; q_ < 8; ++q_) RG[p_][q_] = z2;
#define SCAN_LOAD(cc) do { \
        _Pragma("unroll") for (int p_ = 0; p_ < 2; ++p_) { const int tau = p_ * 16 + tq, t_ = (cc) * 32 + tau; if (t_ < LP) { \
            const bf16_t* bp = PS + (rowbase + t_) * DSHIFT + col; \
            RG[p_][0] = *(const u32x2*)bp; RG[p_][1] = *(const u32x2*)(bp + 1024); RG[p_][2] = *(const u32x2*)(bp + 2048); \
            if (t_ > 0) { RG[p_][3] = *(const u32x2*)(bp - DSHIFT); RG[p_][4] = *(const u32x2*)(bp - DSHIFT + 1024); RG[p_][5] = *(const u32x2*)(bp - DSHIFT + 2048); } \
            else { RG[p_][3] = z2; RG[p_][4] = z2; RG[p_][5] = z2; } \
            const size_t eo = (rowbase + t_) * DM + col; RG[p_][6] = *(const u32x2*)(Eb + eo); RG[p_][7] = *(const u32x2*)(Ab + eo); } } } while (0)
#define SCAN_BUILD(cc) do { LAS float* vb_ = vec + ((cc) & 1) * 12288; LAS float* bb_ = beta + ((cc) & 1) * 32; LAS float* sc_ = scal + ((cc) & 1) * 64; \
        _Pragma("unroll") for (int p_ = 0; p_ < 2; ++p_) { const int tau = p_ * 16 + tq, t_ = (cc) * 32 + tau; if (t_ < LP) { \
            const u32x2 pr = RG[p_][0], pk = RG[p_][1], pv = RG[p_][2], qr = RG[p_][3], qk = RG[p_][4], qv = RG[p_][5], pe = RG[p_][6], pa = RG[p_][7]; \
            float r[4] = {bflo(pr[0]), bfhi(pr[0]), bflo(pr[1]), bfhi(pr[1])}, k[4] = {bflo(pk[0]), bfhi(pk[0]), bflo(pk[1]), bfhi(pk[1])}, v[4] = {bflo(pv[0]), bfhi(pv[0]), bflo(pv[1]), bfhi(pv[1])}; \
            const float xr[4] = {bflo(qr[0]), bfhi(qr[0]), bflo(qr[1]), bfhi(qr[1])}, xk[4] = {bflo(qk[0]), bfhi(qk[0]), bflo(qk[1]), bfhi(qk[1])}, xv[4] = {bflo(qv[0]), bfhi(qv[0]), bflo(qv[1]), bfhi(qv[1])}; \
            const float e[4] = {bflo(pe[0]), bfhi(pe[0]), bflo(pe[1]), bfhi(pe[1])}, aa[4] = {bflo(pa[0]), bfhi(pa[0]), bflo(pa[1]), bfhi(pa[1])}; \
            float kk[4], kh[4], ssq = 0.f, bp_ = 0.f, br_ = 0.f, kr_ = 0.f; \
            _Pragma("unroll") for (int i = 0; i < 4; ++i) { r[i] += (xr[i] - r[i]) * mu_r[i]; k[i] += (xk[i] - k[i]) * mu_k[i]; v[i] += (xv[i] - v[i]) * mu_v[i]; \
                kk[i] = k[i] * kkc[i]; ssq += kk[i] * kk[i]; kh[i] = k[i] * (1.f + (aa[i] - 1.f) * kac[i]); bp_ += r[i] * kh[i] * rkc[i]; br_ += kk[i] * aa[i] * r[i]; kr_ += kh[i] * r[i]; } \
              \
            ssq += dppf<0xB1>(ssq); bp_ += dppf<0xB1>(bp_); br_ += dppf<0xB1>(br_); kr_ += dppf<0xB1>(kr_); \
            ssq += dppf<0x4E>(ssq); bp_ += dppf<0x4E>(bp_); br_ += dppf<0x4E>(br_); kr_ += dppf<0x4E>(kr_); \
            ssq += dppf<0x141>(ssq); bp_ += dppf<0x141>(bp_); br_ += dppf<0x141>(br_); kr_ += dppf<0x141>(kr_); \
            ssq += dppf<0x128>(ssq); bp_ += dppf<0x128>(bp_); br_ += dppf<0x128>(br_); kr_ += dppf<0x128>(kr_); \
            const float inv = fminf(__builtin_amdgcn_rsqf(ssq), 1e12f);     \
            br_ *= inv; \
            LAS float* vp = vb_ + tau * 384 + c4; \
            const float w_[4] = {__expf(e[0]), __expf(e[1]), __expf(e[2]), __expf(e[3])}; \
            *(LAS f32x4*)(vp) = (f32x4){w_[0] * r[0], w_[1] * r[1], w_[2] * r[2], w_[3] * r[3]}; \
            *(LAS f32x4*)(vp + 64) = (f32x4){w_[0], w_[1], w_[2], w_[3]}; \
            *(LAS f32x4*)(vp + 128) = (f32x4){kh[0], kh[1], kh[2], kh[3]}; \
            *(LAS f32x4*)(vp + 192) = (f32x4){-kk[0] * inv, -kk[1] * inv, -kk[2] * inv, -kk[3] * inv}; \
            *(LAS f32x4*)(vp + 256) = (f32x4){kk[0] * inv * aa[0], kk[1] * inv * aa[1], kk[2] * inv * aa[2], kk[3] * inv * aa[3]}; \
            *(LAS f32x4*)(vp + 320) = (f32x4){v[0], v[1], v[2], v[3]}; \
            if ((ht & 15) == 0) { bb_[tau] = bp_; sc_[2 * tau] = br_; sc_[2 * tau + 1] = kr_; } } } } while (0)
#define SCAN_POST(cc) do { const LAS float* yb_ = ybuf + ((cc) & 1) * 1024; const LAS float* bb_ = beta + ((cc) & 1) * 32; \
        const int tau = ht >> 3, r4 = (ht & 7) * 4, t_ = (cc) * 32 + tau; if (t_ < LP) { \
            const f32x4 y4 = *(const LAS f32x4*)(yb_ + tau * 32 + r4); \
            u32x2 w_; w_[0] = pk2(y4[0], y4[1]); w_[1] = pk2(y4[2], y4[3]); \
            *(u32x2*)(YR + (rowbase + t_) * DM + h * 64 + half * 32 + r4) = w_; \
            if (half == 0 && (ht & 7) == 0) BETA[(rowbase + t_) * 16 + h] = bb_[tau]; } } while (0)
        SCAN_LOAD(0);
        SCAN_BUILD(0);
        SCAN_LOAD(1);
        SCAN_BAR();
        for (int c = 0; c < nchunk; ++c) {
            if (c >= 1) SCAN_POST(c - 1);
            if (c + 1 < nchunk) SCAN_BUILD(c + 1);
            if (c + 2 < nchunk) SCAN_LOAD(c + 2);
            SCAN_BAR();
        }
        SCAN_POST(nchunk - 1);
#undef SCAN_LOAD
#undef SCAN_BUILD
#undef SCAN_POST
#undef SCAN_BAR
    }
}

__device__ __forceinline__ void scan_sample(const Args& a, LAS float* lds, int l, int s, int hh) {
    unsigned char* ws = a.ws;
    const bf16_t* PS = (const bf16_t*)(ws + OFF_PS); const bf16_t* Eb = (const bf16_t*)(ws + OFF_E); const bf16_t* Ab = (const bf16_t*)(ws + OFF_A);
    bf16_t* YR = (bf16_t*)(ws + OFF_YRAW); float* BETA = (float*)(ws + OFF_BETA);
    LAS float* vec = lds; LAS float* ybuf = lds + 32 * 384; LAS float* beta = ybuf + 32 * 64;
    const int tid = otid(), lane = tid & 63, wid = tid >> 6;
    const int hl = tid >> 4, c4 = (tid & 15) * 4, head = hh * 8 + hl, col = head * 64 + c4;
    const int rl = lane >> 3, cq = (lane & 7) * 4, vrow = wid * 8 + rl;
    const size_t row = (size_t)MP + s;
    __syncthreads();
    if (tid < 128) {
        const float* mus = a.in[11] + (size_t)l * DSHIFT; const float* sh = a.in[3] + ((size_t)l * NS + s) * DSHIFT;
        const bf16_t* bp = PS + row * DSHIFT + col;
        const u32x2 pr = *(const u32x2*)bp, pk = *(const u32x2*)(bp + 1024), pv = *(const u32x2*)(bp + 2048);
        const f32x4 qr = *(const f32x4*)(sh + col), qk = *(const f32x4*)(sh + 1024 + col), qv = *(const f32x4*)(sh + 2048 + col);
        const f32x4 mu_r = *(const f32x4*)(mus + col), mu_k = *(const f32x4*)(mus + 1024 + col), mu_v = *(const f32x4*)(mus + 2048 + col);
        const f32x4 kkc = *(const f32x4*)(a.in[17] + l * DM + col), kac = *(const f32x4*)(a.in[18] + l * DM + col), rkc = *(const f32x4*)(a.in[19] + l * DM + col);
        const u32x2 pe = *(const u32x2*)(Eb + row * DM + col), pa = *(const u32x2*)(Ab + row * DM + col);
        float r[4], k[4], v[4], e[4], aa[4];
        r[0] = bflo(pr[0]); r[1] = bfhi(pr[0]); r[2] = bflo(pr[1]); r[3] = bfhi(pr[1]);
        k[0] = bflo(pk[0]); k[1] = bfhi(pk[0]); k[2] = bflo(pk[1]); k[3] = bfhi(pk[1]);
        v[0] = bflo(pv[0]); v[1] = bfhi(pv[0]); v[2] = bflo(pv[1]); v[3] = bfhi(pv[1]);
        e[0] = bflo(pe[0]); e[1] = bfhi(pe[0]); e[2] = bflo(pe[1]); e[3] = bfhi(pe[1]);
        aa[0] = bflo(pa[0]); aa[1] = bfhi(pa[0]); aa[2] = bflo(pa[1]); aa[3] = bfhi(pa[1]);
        float kk[4], kh[4], ssq = 0.f, bpv = 0.f;
#pragma unroll
        for (int i = 0; i < 4; ++i) {
            r[i] += (qr[i] - r[i]) * mu_r[i]; k[i] += (qk[i] - k[i]) * mu_k[i]; v[i] += (qv[i] - v[i]) * mu_v[i];
            kk[i] = k[i] * kkc[i]; ssq += kk[i] * kk[i]; kh[i] = k[i] * (1.f + (aa[i] - 1.f) * kac[i]); bpv += r[i] * kh[i] * rkc[i];
        }
        ssq = red16(ssq); bpv = red16(bpv);
        const float inv = fminf(__builtin_amdgcn_rsqf(ssq), 1e12f);
        LAS float* vp = vec + hl * 384 + c4;
        *(LAS f32x4*)(vp) = (f32x4){r[0], r[1], r[2], r[3]};
        *(LAS f32x4*)(vp + 64) = (f32x4){__expf(e[0]), __expf(e[1]), __expf(e[2]), __expf(e[3])};
        *(LAS f32x4*)(vp + 128) = (f32x4){kh[0], kh[1], kh[2], kh[3]};
        *(LAS f32x4*)(vp + 192) = (f32x4){-kk[0] * inv, -kk[1] * inv, -kk[2] * inv, -kk[3] * inv};
        *(LAS f32x4*)(vp + 256) = (f32x4){kk[0] * inv * aa[0], kk[1] * inv * aa[1], kk[2] * inv * aa[2], kk[3] * inv * aa[3]};
        *(LAS f32x4*)(vp + 320) = (f32x4){v[0], v[1], v[2], v[3]};
        if ((tid & 15) == 0) beta[hl] = bpv;
    }
    __syncthreads();
    f32x4 st0[8], st1[8];
#pragma unroll
    for (int h8 = 0; h8 < 8; ++h8) {
        const float* sp = a.in[2] + ((((size_t)l * NS + s) * 16 + hh * 8 + h8) * 64 + vrow) * 64 + cq;
        st0[h8] = *(const f32x4*)sp; st1[h8] = *(const f32x4*)(sp + 32);
    }
#pragma unroll
    for (int h8 = 0; h8 < 8; ++h8) {
        const int h = hh * 8 + h8;
        const size_t so = ((((size_t)l * NS + s) * 16 + h) * 64 + vrow) * 64 + cq;
        const f32x4 s0 = st0[h8], s1 = st1[h8];
        float S[8] = {s0[0], s0[1], s0[2], s0[3], s1[0], s1[1], s1[2], s1[3]};
        const LAS float* vp = vec + h8 * 384 + cq;
        const f32x4 r0 = *(const LAS f32x4*)(vp), r1 = *(const LAS f32x4*)(vp + 32);
        const f32x4 w0 = *(const LAS f32x4*)(vp + 64), w1 = *(const LAS f32x4*)(vp + 96);
        const f32x4 k0 = *(const LAS f32x4*)(vp + 128), k1 = *(const LAS f32x4*)(vp + 160);
        const f32x4 a0 = *(const LAS f32x4*)(vp + 192), a1 = *(const LAS f32x4*)(vp + 224);
        const f32x4 b0 = *(const LAS f32x4*)(vp + 256), b1 = *(const LAS f32x4*)(vp + 288);
        const float vv = vec[h8 * 384 + 320 + vrow];
        float sa = 0.f;
#pragma unroll
        for (int j = 0; j < 4; ++j) { sa += S[j] * a0[j]; sa += S[4 + j] * a1[j]; }
        sa = red8(sa);
        float y = 0.f;
#pragma unroll
        for (int j = 0; j < 4; ++j) {
            S[j] = S[j] * w0[j] + sa * b0[j] + vv * k0[j]; S[4 + j] = S[4 + j] * w1[j] + sa * b1[j] + vv * k1[j];
            y += S[j] * r0[j]; y += S[4 + j] * r1[j];
        }
        y = red8(y);
        if ((lane & 7) == 0) ybuf[h8 * 64 + vrow] = y;
        float* dp = a.out + O_WKVS + so;
        *(f32x4*)dp = (f32x4){S[0], S[1], S[2], S[3]}; *(f32x4*)(dp + 32) = (f32x4){S[4], S[5], S[6], S[7]};
    }
    __syncthreads();
    if (tid < 128) {
        const f32x4 y4 = *(const LAS f32x4*)(ybuf + hl * 64 + c4);
        u32x2 w; w[0] = pk2(y4[0], y4[1]); w[1] = pk2(y4[2], y4[3]);
        *(u32x2*)(YR + row * DM + col) = w;
        if ((tid & 15) == 0) BETA[row * 16 + head] = beta[hl];
    }
}

__device__ __forceinline__ void phase_mix(const Args& a, int l) {
    unsigned char* ws = a.ws; bf16_t* PS = (bf16_t*)(ws + OFF_PS);
    const bf16_t* SAb = (const bf16_t*)(ws + OFF_E); const bf16_t* Qb = (const bf16_t*)(ws + OFF_A); const bf16_t* Ub = (const bf16_t*)(ws + OFF_PS) + 1024;
    const bf16_t* YR = (const bf16_t*)(ws + OFF_YRAW); const float* BETA = (const float*)(ws + OFF_BETA); const bf16_t* SA0 = (const bf16_t*)(ws + OFF_SA0);
    const float* cw = a.in[22] + (size_t)l * 3 * DM; const float* conv0 = a.in[4] + (size_t)l * NS * 2 * DM;
    const float* muv = a.in[11] + (size_t)l * DSHIFT + 2048; const float* sh0 = a.in[3] + (size_t)l * NS * DSHIFT + 2048;
    const float* lnw = a.in[20] + l * DM; const float* lnb = a.in[21] + l * DM;
    const int tid = otid();
    const int c8 = (tid & 127) * 8;
    float pm_[8], pw_[8], pb_[8], c0_[8], c1_[8], c2_[8];
    { const f32x4 a0 = *(const f32x4*)(muv + c8), a1 = *(const f32x4*)(muv + c8 + 4), b0 = *(const f32x4*)(lnw + c8), b1 = *(const f32x4*)(lnw + c8 + 4), d0 = *(const f32x4*)(lnb + c8), d1 = *(const f32x4*)(lnb + c8 + 4);
      const f32x4 e0 = *(const f32x4*)(cw + c8), e1 = *(const f32x4*)(cw + c8 + 4), f0 = *(const f32x4*)(cw + DM + c8), f1 = *(const f32x4*)(cw + DM + c8 + 4), g0 = *(const f32x4*)(cw + 2 * DM + c8), g1 = *(const f32x4*)(cw + 2 * DM + c8 + 4);
#pragma unroll
      for (int i = 0; i < 4; ++i) { pm_[i] = a0[i]; pm_[4 + i] = a1[i]; pw_[i] = b0[i]; pw_[4 + i] = b1[i]; pb_[i] = d0[i]; pb_[4 + i] = d1[i]; c0_[i] = e0[i]; c0_[4 + i] = e1[i]; c1_[i] = f0[i]; c1_[4 + i] = f1[i]; c2_[i] = g0[i]; c2_[4 + i] = g1[i]; } }
    struct MixIn { u32x4 g4, yr, vr, sa, q, u0, p1, p2, pv; f32x4 x0, x1, y0, y1, s0, s1; float bt; };
    auto mix_load = [&](int it, MixIn& r) {
        const int row = it >> 7;
        r.g4 = *(const u32x4*)((const bf16_t*)(ws + OFF_G) + (size_t)row * DM + c8);
        r.yr = *(const u32x4*)(YR + (size_t)row * DM + c8); r.vr = *(const u32x4*)(PS + (size_t)row * DSHIFT + 2048 + c8);
        r.sa = c8 < 256 ? *(const u32x4*)(SA0 + (size_t)row * 256 + c8) : *(const u32x4*)(SAb + (size_t)row * DM + c8);
        r.q = *(const u32x4*)(Qb + (size_t)row * DM + c8); r.u0 = *(const u32x4*)(Ub + (size_t)row * DSHIFT + c8);
        r.bt = BETA[(size_t)row * 16 + (c8 >> 6)];
        r.p1 = (u32x4){0u, 0u, 0u, 0u}; r.p2 = r.p1; r.pv = r.p1;
        if (row >= MP) {
            const float* c1 = conv0 + (size_t)((row - MP) * 2 + 1) * DM + c8; const float* c0 = conv0 + (size_t)((row - MP) * 2) * DM + c8;
            const float* sp = sh0 + (size_t)(row - MP) * DSHIFT + c8;
            r.x0 = *(const f32x4*)c1; r.x1 = *(const f32x4*)(c1 + 4); r.y0 = *(const f32x4*)c0; r.y1 = *(const f32x4*)(c0 + 4); r.s0 = *(const f32x4*)sp; r.s1 = *(const f32x4*)(sp + 4);
        } else {
            const int b = row / LP, t = row - b * LP;
            if (t >= 1) { r.p1 = *(const u32x4*)(Ub + (size_t)(row - 1) * DSHIFT + c8); r.pv = *(const u32x4*)(PS + (size_t)(row - 1) * DSHIFT + 2048 + c8); }
            if (t >= 2) r.p2 = *(const u32x4*)(Ub + (size_t)(row - 2) * DSHIFT + c8);
        }
    };
    auto mix_compute = [&](int it, const MixIn& r) {
        const int row = it >> 7;
        float u1[8], u2[8], vp[8];
        if (row >= MP) {
#pragma unroll
            for (int i = 0; i < 4; ++i) { u1[i] = r.x0[i]; u1[4 + i] = r.x1[i]; u2[i] = r.y0[i]; u2[4 + i] = r.y1[i]; vp[i] = r.s0[i]; vp[4 + i] = r.s1[i]; }
        } else {
#pragma unroll
            for (int i = 0; i < 4; ++i) { u1[2 * i] = bflo(r.p1[i]); u1[2 * i + 1] = bfhi(r.p1[i]); u2[2 * i] = bflo(r.p2[i]); u2[2 * i + 1] = bfhi(r.p2[i]); vp[2 * i] = bflo(r.pv[i]); vp[2 * i + 1] = bfhi(r.pv[i]); }
        }
        float y[8];
#pragma unroll
        for (int i = 0; i < 4; ++i) { y[2 * i] = bflo(r.yr[i]); y[2 * i + 1] = bfhi(r.yr[i]); }
        float s1 = ((y[0] + y[1]) + (y[2] + y[3])) + ((y[4] + y[5]) + (y[6] + y[7]));
        s1 = red8(s1);
        const float mean = s1 * (1.f / 64.f);
        float s2 = 0.f;
#pragma unroll
        for (int i = 0; i < 8; ++i) { y[i] -= mean; s2 += y[i] * y[i]; }
        s2 = red8(s2);
        const float rstd = rsqrtf(s2 * (1.f / 64.f) + 64e-5f);
        float o[8];
#pragma unroll
        for (int i = 0; i < 8; ++i) {
            const int w = i >> 1; const bool hi = i & 1;
            const float vraw = hi ? bfhi(r.vr[w]) : bflo(r.vr[w]);
            const float vv = vraw + (vp[i] - vraw) * pm_[i];
            const float sv = hi ? bfhi(r.sa[w]) : bflo(r.sa[w]), qv = hi ? bfhi(r.q[w]) : bflo(r.q[w]), uv = hi ? bfhi(r.u0[w]) : bflo(r.u0[w]);
            o[i] = (y[i] * rstd * pw_[i] + pb_[i] + r.bt * vv);
            const float z = c0_[i] * u2[i] + c1_[i] * u1[i] + c2_[i] * uv;
            y[i] = qv * z; u1[i] = sv;
        }
        u32x4 w;
#pragma unroll
        for (int i = 0; i < 4; ++i) { const float m0 = u1[2 * i] * (o[2 * i] * bflo(r.g4[i])) + y[2 * i], m1 = u1[2 * i + 1] * (o[2 * i + 1] * bfhi(r.g4[i])) + y[2 * i + 1]; w[i] = pk2(m0, m1); }
        *(u32x4*)(PS + (size_t)row * DSHIFT + c8) = w;
    };
    const int step = gridDim.x * 512, total = M * 128;
    for (int it = blockIdx.x * 512 + tid; it < total; it += 2 * step) {
        MixIn A, B;
        const bool hasB = it + step < total;
        mix_load(it, A);
        if (hasB) mix_load(it + step, B);
        mix_compute(it, A);
        if (hasB) mix_compute(it + step, B);
    }
}

__device__ __forceinline__ void phase_final(const Args& a) {
    unsigned char* ws = a.ws; const bf16_t* XB = (const bf16_t*)(ws + OFF_E);
    const float* SS = (const float*)(ws + OFF_SS); const float* nf = a.in[27];
    const int tid = otid(), lane = tid & 63, wid = tid >> 6;
    f32x4 g[4];
#pragma unroll
    for (int i = 0; i < 4; ++i) g[i] = *(const f32x4*)(nf + lane * 4 + i * 256);
    auto dst_of = [&](int row) -> float* {
        if (row >= M) return nullptr;
        if (row >= MP) return a.out + O_YS + (size_t)(row - MP) * DM;
        const int b = row / LP, t = row - b * LP; if (t < NMETA) return nullptr;
        return a.out + O_YP + ((size_t)b * SEQ + (t - NMETA)) * DM; };
    for (int row = blockIdx.x * 8 + wid; row < M; row += 2 * gridDim.x * 8) {
        const int rowB = row + gridDim.x * 8;
        float* dA = dst_of(row); float* dB = dst_of(rowB);
        u32x2 hA[4], hB[4]; float rsA = 0.f, rsB = 0.f;
        if (dA) { rsA = row_rstd(SS, row);
#pragma unroll
            for (int i = 0; i < 4; ++i) hA[i] = *(const u32x2*)(XB + (size_t)row * DM + lane * 4 + i * 256); }
        if (dB) { rsB = row_rstd(SS, rowB);
#pragma unroll
            for (int i = 0; i < 4; ++i) hB[i] = *(const u32x2*)(XB + (size_t)rowB * DM + lane * 4 + i * 256); }
        if (dA) {
#pragma unroll
            for (int i = 0; i < 4; ++i) { const f32x4 v = (f32x4){bflo(hA[i][0]), bfhi(hA[i][0]), bflo(hA[i][1]), bfhi(hA[i][1])}; *(f32x4*)(dA + lane * 4 + i * 256) = v * rsA * g[i]; } }
        if (dB) {
#pragma unroll
            for (int i = 0; i < 4; ++i) { const f32x4 v = (f32x4){bflo(hB[i][0]), bfhi(hB[i][0]), bflo(hB[i][1]), bfhi(hB[i][1])}; *(f32x4*)(dB + lane * 4 + i * 256) = v * rsB * g[i]; } }
    }
}

__device__ __forceinline__ void gemm_tail_res(LAS float* ldsf, const bf16_t* A, int lda, const bf16_t* Bt, int K, const bf16_t* XB, bf16_t* XBo, float* SS, float scale) {
    const int tid = otid(), lane = tid & 63, wid = tid >> 6;
    const int kw = K >> 3;
    for (int su = blockIdx.x; su < 256; su += gridDim.x) {
        const int row0 = 16384 + (su >> 4) * 16, col0 = (su & 15) * 64;
        f32x4 acc[4];
#pragma unroll
        for (int n = 0; n < 4; ++n) acc[n] = (f32x4){0.f, 0.f, 0.f, 0.f};
        const bf16_t* ap = A + (size_t)(row0 + (lane & 15)) * lda + wid * kw + (lane >> 4) * 8;
        const bf16_t* bp = Bt + (size_t)(col0 + (lane & 15)) * K + wid * kw + (lane >> 4) * 8;
        for (int ks = 0; ks < kw; ks += 32) {
            const bf16x8 af = *(const bf16x8*)(ap + ks);
#pragma unroll
            for (int n = 0; n < 4; ++n) { const bf16x8 bfr = *(const bf16x8*)(bp + (size_t)n * 16 * K + ks); acc[n] = __builtin_amdgcn_mfma_f32_16x16x32_bf16(af, bfr, acc[n], 0, 0, 0); }
        }
#pragma unroll
        for (int n = 0; n < 4; ++n)
#pragma unroll
            for (int j = 0; j < 4; ++j) ldsf[wid * 1024 + ((lane >> 4) * 4 + j) * 64 + n * 16 + (lane & 15)] = acc[n][j];
        __syncthreads();
        { const int r = tid >> 5, c = (tid & 31) * 2; float s0 = 0.f, s1 = 0.f;
#pragma unroll
          for (int w = 0; w < 8; ++w) { const f32x2 v = *(const LAS f32x2*)(ldsf + w * 1024 + r * 64 + c); s0 += v[0]; s1 += v[1]; }
          const size_t o = (size_t)(row0 + r) * DM + col0 + c;
          const unsigned hi = *(const unsigned*)(XB + o);
          f32x2 x; x[0] = bflo(hi) + scale * s0; x[1] = bfhi(hi) + scale * s1;
          *(unsigned*)(XBo + o) = pk2(x[0], x[1]);
          float ss = x[0] * x[0] + x[1] * x[1]; ss = red16(ss); ss += __shfl_xor(ss, 16);
          if ((tid & 31) == 0) SS[(size_t)(row0 + r) * 16 + (su & 15)] = ss; }
        __syncthreads();
    }
}

#define XB_TMO      128
#define XB_XCNT(j)  (256  + 64 * (j))
#define XB_XSUB(j)  (1280 + 64 * (j))
#define XB_XGEN(j)  (2304 + 64 * (j))
#define XB_TOP      3328
#define XB_TOPGEN   3392
#define XCD_BAR_WORDS 3456
#define XB_SPIN_CAP (1u << 18)
__device__ __forceinline__ unsigned xb_ld(unsigned* p)              { return __hip_atomic_load(p, __ATOMIC_RELAXED, __HIP_MEMORY_SCOPE_AGENT); }
__device__ __forceinline__ unsigned xb_add(unsigned* p, unsigned v) { return __hip_atomic_fetch_add(p, v, __ATOMIC_RELAXED, __HIP_MEMORY_SCOPE_AGENT); }
__device__ __forceinline__ unsigned xb_xcc_id() { return (unsigned)__builtin_amdgcn_s_getreg((3 << 11) | 20) & 0xFu; }
#define XB_SPIN(cond, bar) do { unsigned _sp = 0; while (cond) { __builtin_amdgcn_s_sleep(1); \
    if ((++_sp & 255u) == 0u) { if (xb_ld(&(bar)[XB_TMO])) break; if (_sp > XB_SPIN_CAP) { atomicAdd(&(bar)[XB_TMO], 1u); break; } } } } while (0)
struct XcdBarrier { unsigned* bar; unsigned x; volatile LAS unsigned* st; };
__device__ __forceinline__ XcdBarrier xcd_barrier_post(unsigned* bar, volatile LAS unsigned* st) {
    XcdBarrier b; b.bar = bar; b.x = xb_xcc_id(); b.st = st;
    if (threadIdx.x == 0) (void)xb_add(&bar[XB_XCNT(b.x)], 1u);
    return b;
}
__device__ __forceinline__ void xcd_barrier_complete(unsigned* bar, unsigned x, unsigned& nloc, unsigned& nx) {
    const unsigned G = gridDim.x * gridDim.y * gridDim.z;
    unsigned sum, cnt, mine, sp = 0u;
    for (;;) {
        sum = 0u; cnt = 0u; mine = 0u;
#pragma unroll
        for (unsigned j = 0; j < 16; ++j) { const unsigned c = xb_ld(&bar[XB_XCNT(j)]); sum += c; cnt += (c > 0u) ? 1u : 0u; mine = (j == x) ? c : mine; }
        if (sum == G) break;
        __builtin_amdgcn_s_sleep(1);
        if ((++sp & 255u) == 0u) { if (xb_ld(&bar[XB_TMO])) break; if (sp > XB_SPIN_CAP) { atomicAdd(&bar[XB_TMO], 1u); break; } }
    }
    nloc = mine > 0u ? mine : 1u; nx = cnt > 0u ? cnt : 1u;
}
__device__ __forceinline__ void xcd_barrier(const XcdBarrier& b) {
    asm volatile("s_waitcnt vmcnt(0)" ::: "memory");
    __syncthreads();
    if (threadIdx.x == 0) {
        unsigned* bar = b.bar;
        __builtin_amdgcn_s_waitcnt(0);
        unsigned nloc = b.st[0], nx = b.st[1];
        if (nloc == 0u) { xcd_barrier_complete(bar, b.x, nloc, nx); b.st[0] = nloc; b.st[1] = nx; }
        const unsigned old = xb_add(&bar[XB_XSUB(b.x)], 1u);
        const unsigned gen = old / nloc;
        if (old + 1u == (gen + 1u) * nloc) {
            __builtin_amdgcn_fence(__ATOMIC_RELEASE, "agent");
            asm volatile("s_waitcnt vmcnt(0)" ::: "memory");
            const unsigned og = xb_add(&bar[XB_TOP], 1u);
            const unsigned tg = og / nx;
            if (og + 1u == (tg + 1u) * nx) xb_add(&bar[XB_TOPGEN], 1u);
            else XB_SPIN(xb_ld(&bar[XB_TOPGEN]) == tg, bar);
            __builtin_amdgcn_fence(__ATOMIC_ACQUIRE, "agent");
            xb_add(&bar[XB_XGEN(b.x)], 1u);
            asm volatile("s_waitcnt vmcnt(0)" ::: "memory");
        } else {
            XB_SPIN(xb_ld(&bar[XB_XGEN(b.x)]) == gen, bar);
            __builtin_amdgcn_fence(__ATOMIC_ACQUIRE, "agent");
            asm volatile("s_waitcnt vmcnt(0)" ::: "memory");
        }
    }
    __syncthreads();
}

__global__ void __launch_bounds__(512, 2) hybrid_fwd(Args a) {
    extern __shared__ __attribute__((aligned(16))) unsigned char shm_raw[];
    LAS unsigned char* lds = (LAS unsigned char*)shm_raw;
    LAS float* ldsf = (LAS float*)shm_raw;
    cg::grid_group grid = cg::this_grid();
    unsigned char* ws = a.ws;
    volatile LAS unsigned* bst = (volatile LAS unsigned*)(shm_raw + 131072);
    if (threadIdx.x == 0) { bst[0] = 0u; bst[1] = 0u; }
    __syncthreads();
    const XcdBarrier xb = xcd_barrier_post((unsigned*)(ws + OFF_BAR), bst);
    bf16_t* XB = (bf16_t*)a.out; float* SS = (float*)(ws + OFF_SS);
    LAS float* RT = (LAS float*)(shm_raw + LDS_RSTD);
    pg8::StaticOrder S;
    for (int ph = a.ph_lo; ph < a.ph_hi; ++ph) {
      int reps = 1;
#if DUP_MASK
      { const int i_ = (ph - 1) % 11, l_ = (ph - 1) / 11; (void)l_;
        if (ph == 0) { if (DUP_MASK & 1) reps = 2; }
        else if (ph != NPHASE - 1) { if (((DUP_MASK & 2) && (i_ == 0 || i_ == 9)) || ((DUP_MASK & 4) && i_ == 2) || ((DUP_MASK & 8) && i_ == 3) || ((DUP_MASK & 16) && i_ == 4) || ((DUP_MASK & 32) && i_ == 6) || ((DUP_MASK & 64) && i_ == 5) || ((DUP_MASK & 128) && i_ == 7 && l_ == 1)) reps = 2; } }
#endif
      for (int rep = 0; rep < reps; ++rep) {
        if (ph == 0) phase_prologue(a, ldsf);
        else if (ph == NPHASE - 1) phase_final(a);
        else {
            const int l = (ph - 1) / 11, i = (ph - 1) % 11;
            { const int Nph = (i == 0 || i == 9) ? 2 * DFF : (i == 2 ? DSHIFT + 256 : (i == 6 ? 4864 : 0));
              if (Nph) { S.init(M, Nph, gridDim.x, blockIdx.x); prep_rstd(RT, SS, S); } }
            switch (i) {
            case 0: case 9: {
                pg8::Gemm g{XB, (const bf16_t*)(ws + (i == 0 ? OFF_W1 : OFF_W5)), M, 2 * DFF, DM, DM};
                S.init(M, 2 * DFF, gridDim.x, blockIdx.x);
                EpiFfnIn E{RT, (bf16_t*)(ws + OFF_H)};
                pg8::gemm_phase<EpiFfnIn>(lds, g, S, E);
            } break;
            case 1: case 8: case 10: {
                const bool wo = (i == 8);
                pg8::Gemm g{(const bf16_t*)(ws + (wo ? OFF_PS : OFF_H)), (const bf16_t*)(ws + (i == 1 ? OFF_W2 : (wo ? OFF_WO : OFF_W6))), M, DM, wo ? DM : DFF, wo ? DSHIFT : DFF};
                S.init(M - 256, DM, gridDim.x, blockIdx.x);
                const bool fin = (l == 1 && i == 10);
                bf16_t* xbo = fin ? (bf16_t*)(ws + OFF_E) : XB;
                EpiRes E{XB, xbo, SS, wo ? 1.f : 0.5f};
                pg8::gemm_phase<EpiRes>(lds, g, S, E);
                gemm_tail_res(ldsf, g.A, g.lda, g.Bt, g.K, XB, xbo, SS, wo ? 1.f : 0.5f);
            } break;
            case 2: {
                pg8::Gemm g{XB, (const bf16_t*)(ws + OFF_WIN), M, DSHIFT + 256, DM, DM};
                S.init(M, DSHIFT + 256, gridDim.x, blockIdx.x);
                EpiPS E{RT, (bf16_t*)(ws + OFF_PS), a.out + O_SHP + (size_t)l * NB * DSHIFT, a.out + O_SHS + (size_t)l * NS * DSHIFT, (bf16_t*)(ws + OFF_SA0)};
                pg8::gemm_phase<EpiPS>(lds, g, S, E);
            } break;
            case 3:
                phase_lbuild(a, l);
                break;
            case 4: {
                pg8::Gemm g{(const bf16_t*)(ws + OFF_L), (const bf16_t*)(ws + OFF_WL + (size_t)l * SZ_WL), M, 3072, 256, 256};
                S.init(M, 3072, gridDim.x, blockIdx.x);
                EpiLora E{(bf16_t*)(ws + OFF_E), (bf16_t*)(ws + OFF_A), (bf16_t*)(ws + OFF_G), a.in[12] + l * DM, a.in[14] + l * DM};
                pg8::gemm_phase<EpiLora>(lds, g, S, E);
            } break;
            case 5:
                for (int u = blockIdx.x; u < 512; u += gridDim.x) { if (u < 256) scan_prompt(a, ldsf, l, u >> 5, (u >> 1) & 15, u & 1); else scan_sample(a, ldsf, l, (u - 256) >> 1, u & 1); }
                break;
            case 6: {
                pg8::Gemm g{XB, (const bf16_t*)(ws + OFF_WIN + (size_t)(DSHIFT + 256) * DM * 2), M, 4864, DM, DM};
                S.init(M, 4864, gridDim.x, blockIdx.x);
                EpiCG E{RT, (bf16_t*)(ws + OFF_E), (bf16_t*)(ws + OFF_A), (bf16_t*)(ws + OFF_PS) + 1024, a.out + O_CVP + (size_t)l * NB * 2 * DM, a.out + O_CVS + (size_t)l * NS * 2 * DM,
                        a.in[4] + (size_t)l * NS * 2 * DM};
                pg8::gemm_phase<EpiCG>(lds, g, S, E);
            } break;
            case 7:
                phase_mix(a, l);
                break;
            }
        }
      }
        {
            unsigned jobs = 0u;
            if (ph == 0) jobs = 0x3Fu;
            else if (ph != NPHASE - 1) {
                const int l = (ph - 1) / 11, i = (ph - 1) % 11;
                if (l == 0 && i == 7) jobs = 0x7u << 6;
                else if (l == 1 && i == 3) jobs = 0x38u << 6;
            }
            if (jobs) conv_jobs(a, ldsf, jobs, blockIdx.x, gridDim.x);
        }
        if (ph + 1 < a.ph_hi) { if (a.ph_lo < 0) grid.sync(); else xcd_barrier(xb); }
    }
}

extern "C" void kernel_launch(void* const* d_in, const int* in_sizes, int n_in, void* d_out, int out_size, void* d_ws, size_t ws_size, hipStream_t stream) {
    static int grid = 0;
    if (grid == 0) {
        if (n_in != 28 || (size_t)out_size != O_END || ws_size < WS_END) {
            fprintf(stderr, "kernel_launch: unexpected shapes: n_in %d out_size %d ws_size %zu (need %zu)\n", n_in, out_size, ws_size, (size_t)WS_END); grid = -1; return; }
        int dev = 0, cus = 0, per_cu = 0;
        if (hipGetDevice(&dev) != hipSuccess || hipDeviceGetAttribute(&cus, hipDeviceAttributeMultiprocessorCount, dev) != hipSuccess) { grid = -1; return; }
        if (hipFuncSetAttribute((const void*)hybrid_fwd, hipFuncAttributeMaxDynamicSharedMemorySize, LDS_BYTES) != hipSuccess) { fprintf(stderr, "kernel_launch: hipFuncSetAttribute failed\n"); grid = -1; return; }
        if (hipOccupancyMaxActiveBlocksPerMultiprocessor(&per_cu, (const void*)hybrid_fwd, 512, LDS_BYTES) != hipSuccess || per_cu < 1) { fprintf(stderr, "kernel_launch: occupancy query failed (%d)\n", per_cu); grid = -1; return; }
        grid = cus;
    }
    if (grid < 0) return;
    if (hipMemsetAsync((char*)d_ws + OFF_BAR, 0, 16384, stream) != hipSuccess) { fprintf(stderr, "kernel_launch: memset of barrier words failed\n"); return; }
    Args a{};
    for (int i = 0; i < 28; ++i) a.in[i] = (const float*)d_in[i];
    a.out = (float*)d_out; a.ws = (unsigned char*)d_ws; a.ph_lo = 0; a.ph_hi = NPHASE;
    void* args[] = {&a};
    hipError_t e = hipLaunchCooperativeKernel((const void*)hybrid_fwd, dim3(grid), dim3(512), args, LDS_BYTES, stream);
    if (e != hipSuccess) fprintf(stderr, "kernel_launch: cooperative launch failed: %s (grid %d)\n", hipGetErrorString(e), grid);
}
```

```cpp
#include <hip/hip_runtime.h>
#include <hip/hip_cooperative_groups.h>
#include <cstdio>
#include <cstdint>
namespace cg = cooperative_groups;

#define LAS __attribute__((address_space(3)))
typedef unsigned short bf16_t;
typedef short bf16x8 __attribute__((ext_vector_type(8)));
typedef float f32x4 __attribute__((ext_vector_type(4)));
typedef unsigned u32x4 __attribute__((ext_vector_type(4)));
typedef unsigned u32x2 __attribute__((ext_vector_type(2)));

constexpr int DM = 1024, NB = 8, SEQ = 2048, NMETA = 16, LP = SEQ + NMETA  , NS = 128;
constexpr int MP = NB * LP  , M = MP + NS  ;
constexpr int DFF = 2816, DSHIFT = 3328, DPROJ = 8448;
constexpr size_t O_YP = 0, O_YS = O_YP + (size_t)NB * SEQ * DM, O_WKVP = O_YS + (size_t)NS * DM, O_SHP = O_WKVP + 2ull * NB * 16 * 4096,
                 O_CVP = O_SHP + 2ull * NB * DSHIFT, O_WKVS = O_CVP + 2ull * NB * 2 * DM, O_SHS = O_WKVS + 2ull * NS * 16 * 4096,
                 O_CVS = O_SHS + 2ull * NS * DSHIFT, O_END = O_CVS + 2ull * NS * 2 * DM;
constexpr size_t SZ_W1 = 5632ull * 1024 * 2, SZ_W2 = 1024ull * 2816 * 2, SZ_WIN = 8448ull * 1024 * 2, SZ_WO = 1024ull * 1024 * 2, SZ_WL = 3072ull * 256 * 2;
constexpr size_t OFF_W1 = 0, OFF_W2 = OFF_W1 + SZ_W1, OFF_WIN = OFF_W2 + SZ_W2, OFF_WO = OFF_WIN + SZ_WIN, OFF_W5 = OFF_WO + SZ_WO, OFF_W6 = OFF_W5 + SZ_W1,
                 OFF_WL = OFF_W6 + SZ_W2, OFF_XLO = OFF_WL + 2 * SZ_WL, OFF_YRAW = OFF_XLO + (size_t)M * DM * 2, OFF_SS = OFF_YRAW + (size_t)M * DM * 2, OFF_BETA = OFF_SS + (size_t)M * 16 * 4,
                 OFF_L = OFF_BETA + (size_t)M * 16 * 4,
                 OFF_BIG = OFF_L + (size_t)M * 256 * 2;
constexpr size_t BLK = (size_t)M * DM * 2, SZ_PS = (size_t)M * DSHIFT * 2;
constexpr size_t OFF_PS = OFF_BIG, OFF_E = OFF_PS + SZ_PS, OFF_A = OFF_E + BLK, OFF_G = OFF_A + BLK, OFF_BAR = OFF_G + BLK, OFF_SA0 = OFF_BAR + 16384, WS_END = OFF_SA0 + (size_t)M * 256 * 2;
constexpr size_t OFF_H = OFF_BIG;
constexpr int LDS_RSTD = 131072 + 512;
constexpr int LDS_BYTES = LDS_RSTD + 8 * 256 * 4;
constexpr int NPHASE = 24;
#ifndef DUP_MASK
#define DUP_MASK 0
#endif

struct Args { const float* in[28]; float* out; unsigned char* ws; int ph_lo, ph_hi; };

typedef __bf16 bf16x2_t __attribute__((ext_vector_type(2)));
typedef float f32x2_t __attribute__((ext_vector_type(2)));
__device__ __forceinline__ unsigned pk2(float lo, float hi) { const f32x2_t v = {lo, hi}; const bf16x2_t b = __builtin_convertvector(v, bf16x2_t); return __builtin_bit_cast(unsigned, b); }
__device__ __forceinline__ float bflo(unsigned u) { return __uint_as_float(u << 16); }
__device__ __forceinline__ float bfhi(unsigned u) { return __uint_as_float(u & 0xffff0000u); }
__device__ __forceinline__ int otid() { int t = threadIdx.x; asm volatile("" : "+v"(t)); return t; }
__device__ __forceinline__ float sigm(float x) { return __builtin_amdgcn_rcpf(1.f + __expf(-x)); }
template <int CTRL> __device__ __forceinline__ float dppf(float x) { return __builtin_bit_cast(float, __builtin_amdgcn_mov_dpp(__builtin_bit_cast(int, x), CTRL, 0xf, 0xf, true)); }
__device__ __forceinline__ float red8(float x) { x += dppf<0xB1>(x); x += dppf<0x4E>(x); x += dppf<0x141>(x); return x; }
__device__ __forceinline__ float red16(float x) { x = red8(x); x += dppf<0x128>(x); return x; }
__device__ __forceinline__ float row_rstd(const float* SS, int row) {
    const f32x4* p = (const f32x4*)(SS + (size_t)row * 16);
    const f32x4 a = p[0], b = p[1], c = p[2], d = p[3];
    const float s = ((a[0] + a[1]) + (a[2] + a[3])) + ((b[0] + b[1]) + (b[2] + b[3])) + ((c[0] + c[1]) + (c[2] + c[3])) + ((d[0] + d[1]) + (d[2] + d[3]));
    return rsqrtf(s * (1.f / 1024.f) + 1e-6f);
}

namespace pg8 {
constexpr int BM = 256, BK = 64, HALF = 128, HTB = HALF * BK * 2, STAGE_BYTES = 8 * HTB, NXCD = 8, WGM = 8;
__host__ __device__ __forceinline__ int lds_byte(int r, int c) { const int st = (r >> 4) * 2 + (c >> 5), rr = r & 15, cc = c & 31, ob = rr * 64 + cc * 2; return st * 1024 + (ob ^ (((ob >> 9) & 1) << 5)); }
__host__ __device__ __forceinline__ void stage_rc(int b, int& R, int& C) { const int st = b / 1024, sb = b % 1024, swz = sb ^ (((sb >> 9) & 1) << 5); R = (st >> 1) * 16 + swz / 64; C = (st & 1) * 32 + (swz % 64) / 2; }
__host__ __device__ __forceinline__ int perm32(int rho) { const int n = rho >> 4, i = rho & 15; return 8 * (i >> 2) + 4 * n + (i & 3); }
struct Unit { int pm, pn; };
struct Gemm { const bf16_t* A; const bf16_t* Bt; int M, N, K, lda; };
struct StaticOrder {
    int nM, nN, nwg, G, c;
    __device__ void init(int M_, int N_, int G_, int c_) { nM = M_ / BM; nN = N_ / BM; nwg = nM * nN; G = G_; c = c_; }
    __device__ bool next(int i, Unit& u) const {
        const long L = (long)i * G + c; if (L >= nwg) return false;
        int wgid = (int)L; { const int q = nwg / NXCD, r = nwg % NXCD, xcd = wgid % NXCD, off = wgid / NXCD; wgid = (xcd < r ? xcd * (q + 1) : r * (q + 1) + (xcd - r) * q) + off; }
        const int nig = WGM * nN, gid = wgid / nig, fm = gid * WGM, gsz = (nM - fm) < WGM ? (nM - fm) : WGM;
        u.pm = fm + ((wgid % nig) % gsz); u.pn = (wgid % nig) / gsz; return true;
    }
};

template <class Epi>
__device__ __forceinline__ void gemm_phase(LAS unsigned char* lds, const Gemm g, const StaticOrder& S, const Epi& E) {
    const int tid = otid(), wid = __builtin_amdgcn_readfirstlane(tid >> 6), lane = tid & 63, wr = wid >> 2, wc = wid & 3, fr = lane & 15, fq = lane >> 4;
    int K = g.K, lda = g.lda; asm volatile("" : "+s"(K), "+s"(lda));
    const int nt = K / BK;
    unsigned voffA[2], voffB[2];
#pragma unroll
    for (int i = 0; i < 2; ++i) { int R, C; stage_rc(tid * 16 + i * 8192, R, C); const int Rb = Epi::PERM ? ((R & ~31) + perm32(R & 31)) : R;
        voffA[i] = (unsigned)(R * lda + C) * 2u; voffB[i] = (unsigned)(Rb * K + C) * 2u; }
    const size_t kstep = (size_t)(BK * 2);
    const size_t hstepA = (size_t)HALF * lda * 2, hstepB = (size_t)HALF * K * 2;
    const size_t tstepA = 2 * hstepA, tstepB = 2 * hstepB;
    const unsigned ldsw = (unsigned)wid * 1024u;
    const int aoff = lds_byte(wr * 64 + fr, fq * 8), boff = lds_byte(wc * 32 + fr, fq * 8);
#define PG8_SA(b, h) (((b) * 2 + (h)) * HTB)
#define PG8_SB(b, h) ((4 + (b) * 2 + (h)) * HTB)
#define PG8_STAGE(bufoff, gbase, voff) do { _Pragma("unroll") for (int _i = 0; _i < 2; ++_i) \
        __builtin_amdgcn_global_load_lds((const unsigned*)((const char*)(gbase) + (voff)[_i]), (LAS unsigned*)(lds + (bufoff) + ldsw + _i * 8192), 16, 0, 0); } while (0)
#define PG8_LDA(dst, b, h) do { _Pragma("unroll") for (int m = 0; m < 4; ++m) _Pragma("unroll") for (int k = 0; k < 2; ++k) dst[m][k] = *(const LAS bf16x8*)(lds + PG8_SA(b, h) + aoff + m * 2048 + k * 1024); } while (0)
#define PG8_LDB(dst, b, h) do { _Pragma("unroll") for (int n = 0; n < 2; ++n) _Pragma("unroll") for (int k = 0; k < 2; ++k) dst[n][k] = *(const LAS bf16x8*)(lds + PG8_SB(b, h) + boff + n * 2048 + k * 1024); } while (0)
#define PG8_MMA(ai, bj, At, Bt) do { __builtin_amdgcn_s_setprio(1); _Pragma("unroll") for (int m = 0; m < 4; ++m) _Pragma("unroll") for (int n = 0; n < 2; ++n) _Pragma("unroll") for (int k = 0; k < 2; ++k) \
        acc[ai][bj][m][n] = __builtin_amdgcn_mfma_f32_16x16x32_bf16(Bt[n][k], At[m][k], acc[ai][bj][m][n], 0, 0, 0); __builtin_amdgcn_s_setprio(0); } while (0)
#define PG8_WAIT_V(n) asm volatile("s_waitcnt vmcnt(" #n ")" ::: "memory")
#define PG8_WAIT_L(n) asm volatile("s_waitcnt lgkmcnt(" #n ")" ::: "memory")
#define PG8_BAR __builtin_amdgcn_s_barrier()
#define PG8_SCHED __builtin_amdgcn_sched_barrier(0)
    Unit cur, nxt; int ui = 0;
    if (!S.next(0, cur)) return;
    f32x4 acc[2][2][4][2];
#pragma unroll
    for (int a = 0; a < 2; ++a)
#pragma unroll
        for (int b = 0; b < 2; ++b)
#pragma unroll
            for (int m = 0; m < 4; ++m)
#pragma unroll
                for (int n = 0; n < 2; ++n) acc[a][b][m][n] = (f32x4){0.f, 0.f, 0.f, 0.f};
    bf16x8 At[4][2], B0[2][2], B1[2][2];
    const char* cA = (const char*)g.A + (size_t)cur.pm * tstepA; const char* cB = (const char*)g.Bt + (size_t)cur.pn * tstepB;
    PG8_STAGE(PG8_SB(0, 0), cB, voffB); PG8_STAGE(PG8_SB(0, 1), cB + hstepB, voffB); PG8_STAGE(PG8_SA(0, 0), cA, voffA); PG8_STAGE(PG8_SA(0, 1), cA + hstepA, voffA);
    if (wr == 1) PG8_BAR;
    PG8_WAIT_V(2); PG8_BAR;
    PG8_STAGE(PG8_SB(1, 0), cB + kstep, voffB); PG8_STAGE(PG8_SA(1, 0), cA + kstep, voffA); PG8_STAGE(PG8_SB(1, 1), cB + hstepB + kstep, voffB);
    PG8_WAIT_V(6); PG8_BAR;
    for (;;) {
        const bool has_next = S.next(ui + 1, nxt);
        const char* nA = has_next ? (const char*)g.A + (size_t)nxt.pm * tstepA : cA; const char* nB = has_next ? (const char*)g.Bt + (size_t)nxt.pn * tstepB : cB;
        for (int t = 0; t < nt; t += 2) {
            const bool last = (t == nt - 2);
            const char* a1 = cA + (size_t)(t + 1) * kstep;
            const char* a2 = last ? nA : cA + (size_t)(t + 2) * kstep; const char* b2 = last ? nB : cB + (size_t)(t + 2) * kstep;
            const char* a3 = a2 + kstep; const char* b3 = b2 + kstep;
            PG8_LDB(B0, 0, 0); PG8_LDB(B1, 0, 1); PG8_SCHED; PG8_LDA(At, 0, 0); PG8_STAGE(PG8_SA(1, 1), a1 + hstepA, voffA);
            PG8_WAIT_V(8); PG8_WAIT_L(0); PG8_BAR; PG8_MMA(0, 0, At, B0); PG8_MMA(0, 1, At, B1); PG8_BAR; PG8_SCHED;
            PG8_LDA(At, 0, 1); PG8_STAGE(PG8_SB(0, 0), b2, voffB); PG8_STAGE(PG8_SB(0, 1), b2 + hstepB, voffB); PG8_STAGE(PG8_SA(0, 0), a2, voffA);
            PG8_WAIT_V(8); PG8_WAIT_L(0); PG8_BAR; PG8_MMA(1, 0, At, B0); PG8_MMA(1, 1, At, B1); PG8_BAR; PG8_SCHED;
            PG8_LDB(B0, 1, 0); PG8_LDB(B1, 1, 1); PG8_SCHED; PG8_LDA(At, 1, 0); PG8_STAGE(PG8_SA(0, 1), a2 + hstepA, voffA);
            PG8_WAIT_V(8); PG8_WAIT_L(0); PG8_BAR; PG8_MMA(0, 0, At, B0); PG8_MMA(0, 1, At, B1); PG8_BAR; PG8_SCHED;
            PG8_LDA(At, 1, 1); PG8_STAGE(PG8_SB(1, 0), b3, voffB); PG8_STAGE(PG8_SB(1, 1), b3 + hstepB, voffB); PG8_STAGE(PG8_SA(1, 0), a3, voffA);
            PG8_WAIT_V(8); PG8_WAIT_L(0); PG8_BAR; PG8_MMA(1, 0, At, B0); PG8_MMA(1, 1, At, B1); PG8_BAR; PG8_SCHED;
        }
        if (wr == 0) PG8_BAR;
        E(acc, cur, wr, wc, fr, fq, ui);
        if (!has_next) break;
#pragma unroll
        for (int a = 0; a < 2; ++a)
#pragma unroll
            for (int b = 0; b < 2; ++b)
#pragma unroll
                for (int m = 0; m < 4; ++m)
#pragma unroll
                    for (int n = 0; n < 2; ++n) acc[a][b][m][n] = (f32x4){0.f, 0.f, 0.f, 0.f};
        cur = nxt; cA = nA; cB = nB; ++ui;
        if (wr == 1) PG8_BAR;
    }
    PG8_WAIT_V(0);
    PG8_BAR;
#undef PG8_SA
#undef PG8_SB
#undef PG8_STAGE
#undef PG8_LDA
#undef PG8_LDB
#undef PG8_MMA
#undef PG8_WAIT_V
#undef PG8_WAIT_L
#undef PG8_BAR
#undef PG8_SCHED
}
}

__device__ __forceinline__ void prep_rstd(LAS float* tab, const float* SS, const pg8::StaticOrder& S) {
    const int tid = otid(), r = tid >> 1, h = tid & 1;
#pragma unroll 1
    for (int i0 = 0; i0 < 8; i0 += 4) {
        f32x4 p0[4], p1[4]; bool ok[4];
#pragma unroll
        for (int q = 0; q < 4; ++q) { pg8::Unit u; ok[q] = S.next(i0 + q, u);
            if (ok[q]) { const float* sp = SS + (size_t)(u.pm * 256 + r) * 16 + h * 8; p0[q] = *(const f32x4*)sp; p1[q] = *(const f32x4*)(sp + 4); } }
#pragma unroll
        for (int q = 0; q < 4; ++q) if (ok[q]) {
            float s = ((p0[q][0] + p0[q][1]) + (p0[q][2] + p0[q][3])) + ((p1[q][0] + p1[q][1]) + (p1[q][2] + p1[q][3]));
            s += dppf<0xB1>(s);
            if (h == 0) tab[(i0 + q) * 256 + r] = rsqrtf(s * (1.f / 1024.f) + 1e-6f);
        }
    }
    __syncthreads();
}
__device__ __forceinline__ void rows_rstd(const LAS float* tab, int ui, int wr, int fr, float (&rs)[2][4]) {
#pragma unroll
    for (int ai = 0; ai < 2; ++ai)
#pragma unroll
        for (int m = 0; m < 4; ++m) rs[ai][m] = tab[(ui & 7) * 256 + ai * 128 + wr * 64 + m * 16 + fr];
}


typedef const f32x4 (&AccRef)[2][2][4][2];

struct EpiFfnIn {
    static constexpr bool PERM = true;
    const LAS float* RT; bf16_t* H;
    __device__ __forceinline__ void operator()(AccRef acc, const pg8::Unit& u, int wr, int wc, int fr, int fq, int ui) const {
        const int row0 = u.pm * 256 + wr * 64 + fr, col0 = u.pn * 128 + wc * 32 + fq * 8;
        float rsv[2][4]; rows_rstd(RT, ui, wr, fr, rsv);
#pragma unroll
        for (int ai = 0; ai < 2; ++ai)
#pragma unroll
            for (int m = 0; m < 4; ++m) {
                __builtin_amdgcn_sched_barrier(0); const int row = row0 + ai * 128 + m * 16; const float rs = rsv[ai][m];
                u32x4 w;
#pragma unroll
                for (int n = 0; n < 2; ++n) {
                    const f32x4 gt = acc[ai][0][m][n] * rs, up = acc[ai][1][m][n] * rs; float h[4];
#pragma unroll
                    for (int i = 0; i < 4; ++i) h[i] = gt[i] * sigm(gt[i]) * up[i];
                    w[2 * n] = pk2(h[0], h[1]); w[2 * n + 1] = pk2(h[2], h[3]);
                }
                *(u32x4*)(H + (size_t)row * DFF + col0) = w;
            }
    }
};

struct EpiRes {
    static constexpr bool PERM = true;
    const bf16_t* XB; bf16_t* XBo; float* SS; float scale;
    __device__ __forceinline__ void operator()(AccRef acc, const pg8::Unit& u, int wr, int wc, int fr, int fq, int ui) const {
        const int row0 = u.pm * 256 + wr * 64 + fr, col0 = u.pn * 256 + wc * 32 + fq * 8;
        u32x4 hi[2][4][2];
#pragma unroll
        for (int ai = 0; ai < 2; ++ai)
#pragma unroll
            for (int m = 0; m < 4; ++m)
#pragma unroll
                for (int bj = 0; bj < 2; ++bj) hi[ai][m][bj] = *(const u32x4*)(XB + (size_t)(row0 + ai * 128 + m * 16) * DM + col0 + bj * 128);
#pragma unroll
        for (int ai = 0; ai < 2; ++ai)
#pragma unroll
            for (int m = 0; m < 4; ++m) {
                __builtin_amdgcn_sched_barrier(0);
                const int row = row0 + ai * 128 + m * 16; float ss = 0.f;
#pragma unroll
                for (int bj = 0; bj < 2; ++bj) {
                    const size_t o = (size_t)row * DM + col0 + bj * 128;
                    float x[8];
#pragma unroll
                    for (int i = 0; i < 4; ++i) { x[2 * i] = bflo(hi[ai][m][bj][i]) + acc[ai][bj][m][i >> 1][(i & 1) * 2] * scale; x[2 * i + 1] = bfhi(hi[ai][m][bj][i]) + acc[ai][bj][m][i >> 1][(i & 1) * 2 + 1] * scale; }
                    u32x4 wh;
#pragma unroll
                    for (int i = 0; i < 4; ++i) { wh[i] = pk2(x[2 * i], x[2 * i + 1]); ss += x[2 * i] * x[2 * i] + x[2 * i + 1] * x[2 * i + 1]; }
                    *(u32x4*)(XBo + o) = wh;
                }
                ss += __shfl_xor(ss, 16); ss += __shfl_xor(ss, 32);
                if (fq == 0) SS[(size_t)row * 16 + u.pn * 4 + wc] = ss;
            }
    }
};

struct EpiPS {
    static constexpr bool PERM = true;
    const LAS float* RT; bf16_t* PS; float* shp; float* shs; bf16_t* SA0;
    __device__ __forceinline__ void operator()(AccRef acc, const pg8::Unit& u, int wr, int wc, int fr, int fq, int ui) const {
        const int row0 = u.pm * 256 + wr * 64 + fr, col0 = u.pn * 256 + wc * 32 + fq * 8;
        float rsv[2][4]; rows_rstd(RT, ui, wr, fr, rsv);
        if (u.pn == 13) {
#pragma unroll
            for (int ai = 0; ai < 2; ++ai)
#pragma unroll
                for (int m = 0; m < 4; ++m) {
                    __builtin_amdgcn_sched_barrier(0); const int row = row0 + ai * 128 + m * 16; const float rs = rsv[ai][m];
#pragma unroll
                    for (int bj = 0; bj < 2; ++bj) {
                        const f32x4 v0 = acc[ai][bj][m][0] * rs, v1 = acc[ai][bj][m][1] * rs;
                        u32x4 w; w[0] = pk2(sigm(v0[0]), sigm(v0[1])); w[1] = pk2(sigm(v0[2]), sigm(v0[3])); w[2] = pk2(sigm(v1[0]), sigm(v1[1])); w[3] = pk2(sigm(v1[2]), sigm(v1[3]));
                        *(u32x4*)(SA0 + (size_t)row * 256 + bj * 128 + wc * 32 + fq * 8) = w;
                    }
                }
            return;
        }
#pragma unroll
        for (int ai = 0; ai < 2; ++ai)
#pragma unroll
            for (int m = 0; m < 4; ++m) {
                __builtin_amdgcn_sched_barrier(0); const int row = row0 + ai * 128 + m * 16; const float rs = rsv[ai][m];
                float* sd = nullptr;
                if (row >= MP) sd = shs + (size_t)(row - MP) * DSHIFT; else { const int b = row / LP; if (row - b * LP == LP - 1) sd = shp + (size_t)b * DSHIFT; }
#pragma unroll
                for (int bj = 0; bj < 2; ++bj) {
                    const int col = col0 + bj * 128;
                    const f32x4 v0 = acc[ai][bj][m][0] * rs, v1 = acc[ai][bj][m][1] * rs;
                    u32x4 w; w[0] = pk2(v0[0], v0[1]); w[1] = pk2(v0[2], v0[3]); w[2] = pk2(v1[0], v1[1]); w[3] = pk2(v1[2], v1[3]);
                    *(u32x4*)(PS + (size_t)row * DSHIFT + col) = w;
                    if (sd) { *(f32x4*)(sd + col) = v0; *(f32x4*)(sd + col + 4) = v1; }
                }
            }
    }
};

struct EpiCG {
    static constexpr bool PERM = true;
    const LAS float* RT; bf16_t *SAb, *Qb, *Ub; float* cvp; float* cvs; const float* conv0;
    __device__ __forceinline__ void operator()(AccRef acc, const pg8::Unit& u, int wr, int wc, int fr, int fq, int ui) const {
        const int row0 = u.pm * 256 + wr * 64 + fr, cw = wc * 32 + fq * 8;
        float rsv[2][4]; rows_rstd(RT, ui, wr, fr, rsv);
        const int pn = u.pn + 1;
        if (pn < 4) {
#pragma unroll
            for (int ai = 0; ai < 2; ++ai)
#pragma unroll
                for (int m = 0; m < 4; ++m) {
                    __builtin_amdgcn_sched_barrier(0); const int row = row0 + ai * 128 + m * 16; const float rs = rsv[ai][m];
#pragma unroll
                    for (int bj = 0; bj < 2; ++bj) {
                        const f32x4 v0 = acc[ai][bj][m][0] * rs, v1 = acc[ai][bj][m][1] * rs;
                        u32x4 w; w[0] = pk2(sigm(v0[0]), sigm(v0[1])); w[1] = pk2(sigm(v0[2]), sigm(v0[3])); w[2] = pk2(sigm(v1[0]), sigm(v1[1])); w[3] = pk2(sigm(v1[2]), sigm(v1[3]));
                        *(u32x4*)(SAb + (size_t)row * DM + pn * 256 + bj * 128 + cw) = w;
                    }
                }
        } else if (pn < 12) {
            const int col = (pn - 4) * 128 + cw;
#pragma unroll
            for (int ai = 0; ai < 2; ++ai)
#pragma unroll
                for (int m = 0; m < 4; ++m) {
                    __builtin_amdgcn_sched_barrier(0); const int row = row0 + ai * 128 + m * 16; const float rs = rsv[ai][m];
                    u32x4 w;
#pragma unroll
                    for (int n = 0; n < 2; ++n) {
                        const f32x4 a = acc[ai][0][m][n] * rs, b = acc[ai][1][m][n] * rs;
                        w[2 * n] = pk2(sigm(a[0]) * b[0], sigm(a[1]) * b[1]); w[2 * n + 1] = pk2(sigm(a[2]) * b[2], sigm(a[3]) * b[3]);
                    }
                    *(u32x4*)(Qb + (size_t)row * DM + col) = w;
                }
        } else {
            const int col = (pn - 12) * 128 + cw;
#pragma unroll
            for (int ai = 0; ai < 2; ++ai)
#pragma unroll
                for (int m = 0; m < 4; ++m) {
                    __builtin_amdgcn_sched_barrier(0); const int row = row0 + ai * 128 + m * 16; const float rs = rsv[ai][m];
                    const f32x4 u0 = (acc[ai][0][m][0] * rs) * (acc[ai][1][m][0] * rs), u1 = (acc[ai][0][m][1] * rs) * (acc[ai][1][m][1] * rs);
                    u32x4 w; w[0] = pk2(u0[0], u0[1]); w[1] = pk2(u0[2], u0[3]); w[2] = pk2(u1[0], u1[1]); w[3] = pk2(u1[2], u1[3]);
                    *(u32x4*)(Ub + (size_t)row * DSHIFT + col) = w;
                    float* cd = nullptr;
                    if (row >= MP) {
                        const int s = row - MP; cd = cvs + (size_t)(s * 2 + 1) * DM + col;
                        const float* cs = conv0 + (size_t)(s * 2 + 1) * DM + col; float* c0 = cvs + (size_t)(s * 2) * DM + col;
                        *(f32x4*)c0 = *(const f32x4*)cs; *(f32x4*)(c0 + 4) = *(const f32x4*)(cs + 4);
                    } else { const int b = row / LP, t = row - b * LP; if (t >= LP - 2) cd = cvp + (size_t)(b * 2 + (t - (LP - 2))) * DM + col; }
                    if (cd) { *(f32x4*)cd = u0; *(f32x4*)(cd + 4) = u1; }
                }
        }
    }
};

struct EpiLora {
    static constexpr bool PERM = true;
    bf16_t *E, *A, *G; const float* w0; const float* a0;
    template <int SEC> __device__ __forceinline__ void run(AccRef acc, bf16_t* dst, const float* bias, int row0, int cb) const {
#pragma unroll
        for (int bj = 0; bj < 2; ++bj) {
            const int col = cb + bj * 128;
            f32x4 b0 = (f32x4){0.f, 0.f, 0.f, 0.f}, b1 = b0;
            if (SEC < 2) { b0 = *(const f32x4*)(bias + col); b1 = *(const f32x4*)(bias + col + 4); }
#pragma unroll
            for (int ai = 0; ai < 2; ++ai)
#pragma unroll
                for (int m = 0; m < 4; ++m) {
                    __builtin_amdgcn_sched_barrier(0); const int row = row0 + ai * 128 + m * 16;
                    const f32x4 v0 = acc[ai][bj][m][0] + b0, v1 = acc[ai][bj][m][1] + b1;
                    u32x4 w;
                    if (SEC == 0) { const float sc = -0.60653065971f;
                        w[0] = pk2(sc * sigm(v0[0]), sc * sigm(v0[1])); w[1] = pk2(sc * sigm(v0[2]), sc * sigm(v0[3])); w[2] = pk2(sc * sigm(v1[0]), sc * sigm(v1[1])); w[3] = pk2(sc * sigm(v1[2]), sc * sigm(v1[3])); }
                    else if (SEC == 1) { w[0] = pk2(sigm(v0[0]), sigm(v0[1])); w[1] = pk2(sigm(v0[2]), sigm(v0[3])); w[2] = pk2(sigm(v1[0]), sigm(v1[1])); w[3] = pk2(sigm(v1[2]), sigm(v1[3])); }
                    else { w[0] = pk2(v0[0], v0[1]); w[1] = pk2(v0[2], v0[3]); w[2] = pk2(v1[0], v1[1]); w[3] = pk2(v1[2], v1[3]); }
                    *(u32x4*)(dst + (size_t)row * DM + col) = w;
                }
        }
    }
    __device__ __forceinline__ void operator()(AccRef acc, const pg8::Unit& u, int wr, int wc, int fr, int fq, int ui) const {
        const int row0 = u.pm * 256 + wr * 64 + fr, sec = u.pn >> 2, cb = (u.pn & 3) * 256 + wc * 32 + fq * 8;
        if (sec == 0) run<0>(acc, E, w0, row0, cb); else if (sec == 1) run<1>(acc, A, a0, row0, cb); else run<2>(acc, G, nullptr, row0, cb);
    }
};

__device__ __forceinline__ int colmap(int MAP, int n) {
    if (MAP == 0) return n;
    if (MAP == 1) { const int pn = n >> 8, w = n & 255, hh = pn * 128 + (w & 127); return (w & 128) ? DFF + hh : hh; }
    if (n < DSHIFT) return n;
    const int np = n - DSHIFT, pn = np >> 8, w = np & 255, j = w & 127, bj = w >> 7;
    if (pn < 4) return 6400 + pn * 256 + w;
    if (pn < 12) { const int ch = (pn - 4) * 128 + j; return bj ? 3328 + ch : 7424 + ch; }
    const int ch = (pn - 12) * 128 + j; return bj ? 5376 + ch : 4352 + ch;
}
__device__ __forceinline__ void conv_weight(LAS float* tile, const float* src, int ldsrc, bf16_t* dst, int N, int K, const float* scale, int MAP, int first, int stride) {
    const int tid = otid(), kt_n = K >> 6, items = (N >> 6) * kt_n;
    f32x4 R[4][2];
#define CW_LOAD(it_) do { _Pragma("unroll") for (int q = 0; q < 4; ++q) { const int itq = (it_) + q * stride; \
        if (itq < items) { const int n0 = (itq / kt_n) << 6, k0 = (itq % kt_n) << 6, c0 = colmap(MAP, n0); \
            _Pragma("unroll") for (int i = 0; i < 2; ++i) { const int f = tid + 512 * i, k = f >> 4, n4 = (f & 15) << 2; \
                R[q][i] = *(const f32x4*)(src + (size_t)(k0 + k) * ldsrc + c0 + n4); } } } } while (0)
    if (first < items) CW_LOAD(first);
    for (int it = first; it < items; it += 4 * stride) {
#pragma unroll
        for (int q = 0; q < 4; ++q) {
            const int itq = it + q * stride;
            if (itq < items) {
                const int k0 = (itq % kt_n) << 6;
#pragma unroll
                for (int i = 0; i < 2; ++i) {
                    const int f = tid + 512 * i, k = f >> 4, n4 = (f & 15) << 2;
                    f32x4 v = R[q][i];
                    if (scale) v *= scale[k0 + k];
                    LAS float* tp = tile + q * 4160 + k * 65 + n4; tp[0] = v[0]; tp[1] = v[1]; tp[2] = v[2]; tp[3] = v[3];
                }
            }
        }
        if (it + 4 * stride < items) CW_LOAD(it + 4 * stride);
        __syncthreads();
#pragma unroll
        for (int q = 0; q < 4; ++q) {
            const int itq = it + q * stride;
            if (itq < items) {
                const int n0 = (itq / kt_n) << 6, k0 = (itq % kt_n) << 6;
                const int n = tid >> 3, kg = (tid & 7) << 3; const LAS float* tp = tile + q * 4160 + kg * 65 + n;
                u32x4 w; w[0] = pk2(tp[0], tp[65]); w[1] = pk2(tp[130], tp[195]); w[2] = pk2(tp[260], tp[325]); w[3] = pk2(tp[390], tp[455]);
                *(u32x4*)(dst + (size_t)(n0 + n) * K + k0 + kg) = w;
            }
        }
        __syncthreads();
    }
#undef CW_LOAD
}
__device__ __forceinline__ void conv_jobs(const Args& a, LAS float* tile, unsigned jobs, int first, int stride) {
    unsigned char* ws = a.ws;
    for (int jb = 0; jb < 12; ++jb) {
        if (!((jobs >> jb) & 1u)) continue;
        const int l = jb / 6, w = jb - l * 6;
        const float* src; const float* scale = nullptr; bf16_t* dst; int ldsrc, N, K, MAP = 0;
        if (w == 0 || w == 4) { src = a.in[w == 0 ? 7 : 25] + (size_t)l * DM * 2 * DFF; ldsrc = 2 * DFF; dst = (bf16_t*)(ws + (w == 0 ? OFF_W1 : OFF_W5)); N = 2 * DFF; K = DM; scale = a.in[w == 0 ? 6 : 24] + l * DM; MAP = 1; }
        else if (w == 1 || w == 5) { src = a.in[w == 1 ? 8 : 26] + (size_t)l * DFF * DM; ldsrc = DM; dst = (bf16_t*)(ws + (w == 1 ? OFF_W2 : OFF_W6)); N = DM; K = DFF; }
        else if (w == 2) { src = a.in[10] + (size_t)l * DM * DPROJ; ldsrc = DPROJ; dst = (bf16_t*)(ws + OFF_WIN); N = DPROJ; K = DM; scale = a.in[9] + l * DM; MAP = 2; }
        else { src = a.in[23] + (size_t)l * DM * DM; ldsrc = DM; dst = (bf16_t*)(ws + OFF_WO); N = DM; K = DM; }
        conv_weight(tile, src, ldsrc, dst, N, K, scale, MAP, first, stride);
    }
}

__device__ __forceinline__ void phase_prologue(const Args& a, LAS float* ldsf) {
    unsigned char* ws = a.ws;
    const int tid = otid(), lane = tid & 63, wid = tid >> 6;
    { bf16_t* XB = (bf16_t*)a.out; float* SS = (float*)(ws + OFF_SS);
      for (int row = blockIdx.x * 8 + wid; row < M; row += gridDim.x * 8) {
          const float* src;
          if (row >= MP) src = a.in[1] + (size_t)(row - MP) * DM;
          else { const int b = row / LP, t = row - b * LP; src = t < NMETA ? a.in[5] + (size_t)t * DM : a.in[0] + ((size_t)b * SEQ + (t - NMETA)) * DM; }
          float ss = 0.f;
#pragma unroll
          for (int i = 0; i < 4; ++i) {
              const int c = lane * 4 + i * 256; const f32x4 v = *(const f32x4*)(src + c);
              u32x2 w; w[0] = pk2(v[0], v[1]); w[1] = pk2(v[2], v[3]); *(u32x2*)(XB + (size_t)row * DM + c) = w;
              ss += (v[0] * v[0] + v[1] * v[1]) + (v[2] * v[2] + v[3] * v[3]);
          }
#pragma unroll
          for (int o = 1; o < 64; o <<= 1) ss += __shfl_xor(ss, o);
          if (lane < 16) SS[(size_t)row * 16 + lane] = lane == 0 ? ss : 0.f;
      } }
    { bf16_t* WL = (bf16_t*)(ws + OFF_WL); const int total = 2 * 32 * 3072;
      for (int i = blockIdx.x * 512 + tid; i < total; i += gridDim.x * 512) {
          const int l = i / (32 * 3072), r = i - l * (32 * 3072), kg = r / 3072, n = r - kg * 3072, sec = n >> 10, ch = n & 1023, k0 = kg * 8;
          float v[8];
#pragma unroll
          for (int jx = 0; jx < 8; ++jx) v[jx] = 0.f;
          if (sec == 0) { if (k0 < 64) {
#pragma unroll
              for (int jx = 0; jx < 8; ++jx) v[jx] = a.in[13][((size_t)l * 64 + k0 + jx) * DM + ch]; } }
          else if (sec == 1) { if (k0 >= 64 && k0 < 128) {
#pragma unroll
              for (int jx = 0; jx < 8; ++jx) v[jx] = a.in[15][((size_t)l * 64 + (k0 - 64) + jx) * DM + ch]; } }
          else { if (k0 >= 128) {
#pragma unroll
              for (int jx = 0; jx < 8; ++jx) v[jx] = a.in[16][((size_t)l * 128 + (k0 - 128) + jx) * DM + ch]; } }
          u32x4 w; w[0] = pk2(v[0], v[1]); w[1] = pk2(v[2], v[3]); w[2] = pk2(v[4], v[5]); w[3] = pk2(v[6], v[7]);
          *(u32x4*)(WL + ((size_t)l * 3072 + n) * 256 + k0) = w;
      } }
}

__device__ __forceinline__ void phase_lbuild(const Args& a, int l) {
    unsigned char* ws = a.ws; const bf16_t* PS = (const bf16_t*)(ws + OFF_PS); bf16_t* L = (bf16_t*)(ws + OFF_L);
    const float* mu = a.in[11] + (size_t)l * DSHIFT + 3072; const float* sh0 = a.in[3] + (size_t)l * NS * DSHIFT;
    const int tid = otid(), jj = tid & 31, j0 = jj * 8;
    const f32x4 m0 = *(const f32x4*)(mu + j0), m1 = *(const f32x4*)(mu + j0 + 4);
    struct LIn { u32x4 cur, pv; f32x4 s0, s1; };
    auto lb_load = [&](int it, LIn& r) {
        const int row = it >> 5;
        r.cur = *(const u32x4*)(PS + (size_t)row * DSHIFT + 3072 + j0); r.pv = (u32x4){0u, 0u, 0u, 0u};
        if (row >= MP) { const float* sp = sh0 + (size_t)(row - MP) * DSHIFT + 3072 + j0; r.s0 = *(const f32x4*)sp; r.s1 = *(const f32x4*)(sp + 4); }
        else { const int b = row / LP, t = row - b * LP; if (t > 0) r.pv = *(const u32x4*)(PS + (size_t)(row - 1) * DSHIFT + 3072 + j0); }
    };
    auto lb_compute = [&](int it, const LIn& r) {
        const int row = it >> 5;
        float c[8], p[8];
#pragma unroll
        for (int i = 0; i < 4; ++i) { c[2 * i] = bflo(r.cur[i]); c[2 * i + 1] = bfhi(r.cur[i]); }
        if (row >= MP) {
#pragma unroll
            for (int i = 0; i < 4; ++i) { p[i] = r.s0[i]; p[4 + i] = r.s1[i]; }
        } else {
#pragma unroll
            for (int i = 0; i < 4; ++i) { p[2 * i] = bflo(r.pv[i]); p[2 * i + 1] = bfhi(r.pv[i]); }
        }
        float o[8];
#pragma unroll
        for (int i = 0; i < 8; ++i) {
            const float mm = i < 4 ? m0[i & 3] : m1[i & 3]; const float xs = c[i] + (p[i] - c[i]) * mm;
            o[i] = jj < 8 ? (1.f - 2.f * __builtin_amdgcn_rcpf(1.f + __expf(2.f * xs))) : (jj < 16 ? xs : sigm(xs));
        }
        u32x4 w; w[0] = pk2(o[0], o[1]); w[1] = pk2(o[2], o[3]); w[2] = pk2(o[4], o[5]); w[3] = pk2(o[6], o[7]);
        *(u32x4*)(L + (size_t)row * 256 + j0) = w;
    };
    const int step = gridDim.x * 512, total = M * 32;
    for (int it = blockIdx.x * 512 + tid; it < total; it += 2 * step) {
        LIn A, B; const bool hasB = it + step < total;
        lb_load(it, A); if (hasB) lb_load(it + step, B);
        lb_compute(it, A); if (hasB) lb_compute(it + step, B);
    }
}

typedef float f32x2 __attribute__((ext_vector_type(2)));
__device__ __forceinline__ void scan_prompt(const Args& a, LAS float* lds, int l, int b, int h, int half) {
    unsigned char* ws = a.ws;
#define SCAN_BAR() asm volatile("s_waitcnt lgkmcnt(0)\n\ts_barrier" ::: "memory")
    const bf16_t* PS = (const bf16_t*)(ws + OFF_PS); const bf16_t* Eb = (const bf16_t*)(ws + OFF_E); const bf16_t* Ab = (const bf16_t*)(ws + OFF_A);
    bf16_t* YR = (bf16_t*)(ws + OFF_YRAW); float* BETA = (float*)(ws + OFF_BETA);
    LAS float* vec = lds; LAS float* ybuf = lds + 2 * 12288; LAS float* beta = ybuf + 2 * 1024; LAS float* scal = beta + 64;
    const int tid = otid(), lane = tid & 63, wid = __builtin_amdgcn_readfirstlane(tid >> 6);
    const size_t rowbase = (size_t)b * LP;
    constexpr int nchunk = (LP + 31) / 32;
    if (wid < 4) {
        const int cg8 = (lane & 7) * 8, rloc = wid * 8 + (lane >> 3), vrow = half * 32 + rloc;
        f32x2 S[4];
#pragma unroll
        for (int j = 0; j < 4; ++j) S[j] = (f32x2){0.f, 0.f};
        SCAN_BAR();
        for (int c = 0; c < nchunk; ++c) {
            const LAS float* vb = vec + (c & 1) * 12288; LAS float* yb = ybuf + (c & 1) * 1024; const LAS float* scb = scal + (c & 1) * 64;
            const int nst = (LP - c * 32) < 32 ? (LP - c * 32) : 32;
#define SV_LOAD(P, s_) do { const LAS float* vp = tp + (s_) * 384;     \
                P##r0 = *(const LAS f32x4*)(vp); P##r1 = *(const LAS f32x4*)(vp + 4); P##w0 = *(const LAS f32x4*)(vp + 64); P##w1 = *(const LAS f32x4*)(vp + 68); \
                P##k0 = *(const LAS f32x4*)(vp + 128); P##k1 = *(const LAS f32x4*)(vp + 132); P##a0 = *(const LAS f32x4*)(vp + 192); P##a1 = *(const LAS f32x4*)(vp + 196); \
                P##b0 = *(const LAS f32x4*)(vp + 256); P##b1 = *(const LAS f32x4*)(vp + 260); P##vv = tv[(s_) * 384]; P##sc = *(const LAS f32x2*)(ts + 2 * (s_)); } while (0)
#define SV_STEP(P, s_) do { \
                const f32x2 rv[4] = {(f32x2){P##r0[0], P##r0[1]}, (f32x2){P##r0[2], P##r0[3]}, (f32x2){P##r1[0], P##r1[1]}, (f32x2){P##r1[2], P##r1[3]}}; \
                const f32x2 wv[4] = {(f32x2){P##w0[0], P##w0[1]}, (f32x2){P##w0[2], P##w0[3]}, (f32x2){P##w1[0], P##w1[1]}, (f32x2){P##w1[2], P##w1[3]}}; \
                const f32x2 kv[4] = {(f32x2){P##k0[0], P##k0[1]}, (f32x2){P##k0[2], P##k0[3]}, (f32x2){P##k1[0], P##k1[1]}, (f32x2){P##k1[2], P##k1[3]}}; \
                const f32x2 av[4] = {(f32x2){P##a0[0], P##a0[1]}, (f32x2){P##a0[2], P##a0[3]}, (f32x2){P##a1[0], P##a1[1]}, (f32x2){P##a1[2], P##a1[3]}}; \
                const f32x2 bv[4] = {(f32x2){P##b0[0], P##b0[1]}, (f32x2){P##b0[2], P##b0[3]}, (f32x2){P##b1[0], P##b1[1]}, (f32x2){P##b1[2], P##b1[3]}}; \
                  \
                f32x2 p = S[0] * av[0], q = S[0] * rv[0]; p = S[1] * av[1] + p; q = S[1] * rv[1] + q; p = S[2] * av[2] + p; q = S[2] * rv[2] + q; p = S[3] * av[3] + p; q = S[3] * rv[3] + q; \
                float sa = p[0] + p[1], yq = q[0] + q[1]; \
                sa += dppf<0xB1>(sa); yq += dppf<0xB1>(yq); sa += dppf<0x4E>(sa); yq += dppf<0x4E>(yq); sa += dppf<0x141>(sa); yq += dppf<0x141>(yq); \
                const f32x2 sa2 = (f32x2){sa, sa}, v2 = (f32x2){P##vv, P##vv}; \
                _Pragma("unroll") for (int j = 0; j < 4; ++j) S[j] = S[j] * wv[j] + (sa2 * bv[j] + v2 * kv[j]); \
                ty[(s_) * 32] = yq + sa * P##sc[0] + P##vv * P##sc[1]; } while (0)
            f32x4 Ar0, Ar1, Aw0, Aw1, Ak0, Ak1, Aa0, Aa1, Ab0, Ab1, Br0, Br1, Bw0, Bw1, Bk0, Bk1, Ba0, Ba1, Bb0, Bb1; float Avv, Bvv; f32x2 Asc, Bsc;
            const LAS float* tp = vb + cg8; const LAS float* tv = vb + 320 + vrow; const LAS float* ts = scb; LAS float* ty = yb + rloc;
            SV_LOAD(A, 0);
            for (int s = 0; s < nst; s += 16) {
                SV_LOAD(B, 1); SV_STEP(A, 0);
                SV_LOAD(A, 2); SV_STEP(B, 1);
                SV_LOAD(B, 3); SV_STEP(A, 2);
                SV_LOAD(A, 4); SV_STEP(B, 3);
                SV_LOAD(B, 5); SV_STEP(A, 4);
                SV_LOAD(A, 6); SV_STEP(B, 5);
                SV_LOAD(B, 7); SV_STEP(A, 6);
                SV_LOAD(A, 8); SV_STEP(B, 7);
                SV_LOAD(B, 9); SV_STEP(A, 8);
                SV_LOAD(A, 10); SV_STEP(B, 9);
                SV_LOAD(B, 11); SV_STEP(A, 10);
                SV_LOAD(A, 12); SV_STEP(B, 11);
                SV_LOAD(B, 13); SV_STEP(A, 12);
                SV_LOAD(A, 14); SV_STEP(B, 13);
                SV_LOAD(B, 15); SV_STEP(A, 14);
                if (s + 16 < nst) SV_LOAD(A, 16);
                SV_STEP(B, 15);
                tp += 16 * 384; tv += 16 * 384; ts += 32; ty += 16 * 32;
            }
#undef SV_LOAD
#undef SV_STEP
            SCAN_BAR();
        }
        { float* dst = a.out + O_WKVP + ((((size_t)l * NB + b) * 16 + h) * 64 + vrow) * 64 + cg8;
          *(f32x4*)dst = (f32x4){S[0][0], S[0][1], S[1][0], S[1][1]}; *(f32x4*)(dst + 4) = (f32x4){S[2][0], S[2][1], S[3][0], S[3][1]}; }
    } else {
        const int ht = tid - 256, tq = ht >> 4, c4 = (ht & 15) * 4, col = h * 64 + c4;
        const float* mus = a.in[11] + (size_t)l * DSHIFT;
        const f32x4 mu_r = *(const f32x4*)(mus + col), mu_k = *(const f32x4*)(mus + 1024 + col), mu_v = *(const f32x4*)(mus + 2048 + col);
        const f32x4 kkc = *(const f32x4*)(a.in[17] + l * DM + col), kac = *(const f32x4*)(a.in[18] + l * DM + col), rkc = *(const f32x4*)(a.in[19] + l * DM + col);
        const u32x2 z2 = (u32x2){0u, 0u};
        u32x2 RG[2][8];
#pragma unroll
        for (int p_ = 0; p_ < 2; ++p_)
#pragma unroll
            for (int q_ = 0; q_ < 8; ++q_) RG[p_][q_] = z2;
#define SCAN_LOAD(cc) do { \
        _Pragma("unroll") for (int p_ = 0; p_ < 2; ++p_) { const int tau = p_ * 16 + tq, t_ = (cc) * 32 + tau; if (t_ < LP) { \
            const bf16_t* bp = PS + (rowbase + t_) * DSHIFT + col; \
            RG[p_][0] = *(const u32x2*)bp; RG[p_][1] = *(const u32x2*)(bp + 1024); RG[p_][2] = *(const u32x2*)(bp + 2048); \
            if (t_ > 0) { RG[p_][3] = *(const u32x2*)(bp - DSHIFT); RG[p_][4] = *(const u32x2*)(bp - DSHIFT + 1024); RG[p_][5] = *(const u32x2*)(bp - DSHIFT + 2048); } \
            else { RG[p_][3] = z2; RG[p_][4] = z2; RG[p_][5] = z2; } \
            const size_t eo = (rowbase + t_) * DM + col; RG[p_][6] = *(const u32x2*)(Eb + eo); RG[p_][7] = *(const u32x2*)(Ab + eo); } } } while (0)
#define SCAN_BUILD(cc) do { LAS float* vb_ = vec + ((cc) & 1) * 12288; LAS float* bb_ = beta + ((cc) & 1) * 32; LAS float* sc_ = scal + ((cc) & 1) * 64; \
        _Pragma("unroll") for (int p_ = 0; p_ < 2; ++p_) { const int tau = p_ * 16 + tq, t_ = (cc) * 32 + tau; if (t_ < LP) { \
            const u32x2 pr = RG[p_][0], pk = RG[p_][1], pv = RG[p_][2], qr = RG[p_][3], qk = RG[p_][4], qv = RG[p_][5], pe = RG[p_][6], pa = RG[p_][7]; \
            float r[4] = {bflo(pr[0]), bfhi(pr[0]), bflo(pr[1]), bfhi(pr[1])}, k[4] = {bflo(pk[0]), bfhi(pk[0]), bflo(pk[1]), bfhi(pk[1])}, v[4] = {bflo(pv[0]), bfhi(pv[0]), bflo(pv[1]), bfhi(pv[1])}; \
            const float xr[4] = {bflo(qr[0]), bfhi(qr[0]), bflo(qr[1]), bfhi(qr[1])}, xk[4] = {bflo(qk[0]), bfhi(qk[0]), bflo(qk[1]), bfhi(qk[1])}, xv[4] = {bflo(qv[0]), bfhi(qv[0]), bflo(qv[1]), bfhi(qv[1])}; \
            const float e[4] = {bflo(pe[0]), bfhi(pe[0]), bflo(pe[1]), bfhi(pe[1])}, aa[4] = {bflo(pa[0]), bfhi(pa[0]), bflo(pa[1]), bfhi(pa[1])}; \
            float kk[4], kh[4], ssq = 0.f, bp_ = 0.f, br_ = 0.f, kr_ = 0.f; \
            _Pragma("unroll") for (int i = 0; i < 4; ++i) { r[i] += (xr[i] - r[i]) * mu_r[i]; k[i] += (xk[i] - k[i]) * mu_k[i]; v[i] += (xv[i] - v[i]) * mu_v[i]; \
                kk[i] = k[i] * kkc[i]; ssq += kk[i] * kk[i]; kh[i] = k[i] * (1.f + (aa[i] - 1.f) * kac[i]); bp_ += r[i] * kh[i] * rkc[i]; br_ += kk[i] * aa[i] * r[i]; kr_ += kh[i] * r[i]; } \
              \
            ssq += dppf<0xB1>(ssq); bp_ += dppf<0xB1>(bp_); br_ += dppf<0xB1>(br_); kr_ += dppf<0xB1>(kr_); \
            ssq += dppf<0x4E>(ssq); bp_ += dppf<0x4E>(bp_); br_ += dppf<0x4E>(br_); kr_ += dppf<0x4E>(kr_); \
            ssq += dppf<0x141>(ssq); bp_ += dppf<0x141>(bp_); br_ += dppf<0x141>(br_); kr_ += dppf<0x141>(kr_); \
            ssq += dppf<0x128>(ssq); bp_ += dppf<0x128>(bp_); br_ += dppf<0x128>(br_); kr_ += dppf<0x128>(kr_); \
            const float inv = fminf(__builtin_amdgcn_rsqf(ssq), 1e12f);     \
            br_ *= inv; \
            LAS float* vp = vb_ + tau * 384 + c4; \
            const float w_[4] = {__expf(e[0]), __expf(e[1]), __expf(e[2]), __expf(e[3])}; \
            *(LAS f32x4*)(vp) = (f32x4){w_[0] * r[0], w_[1] * r[1], w_[2] * r[2], w_[3] * r[3]}; \
            *(LAS f32x4*)(vp + 64) = (f32x4){w_[0], w_[1], w_[2], w_[3]}; \
            *(LAS f32x4*)(vp + 128) = (f32x4){kh[0], kh[1], kh[2], kh[3]}; \
            *(LAS f32x4*)(vp + 192) = (f32x4){-kk[0] * inv, -kk[1] * inv, -kk[2] * inv, -kk[3] * inv}; \
            *(LAS f32x4*)(vp + 256) = (f32x4){kk[0] * inv * aa[0], kk[1] * inv * aa[1], kk[2] * inv * aa[2], kk[3] * inv * aa[3]}; \
            *(LAS f32x4*)(vp + 320) = (f32x4){v[0], v[1], v[2], v[3]}; \
            if ((ht & 15) == 0) { bb_[tau] = bp_; sc_[2 * tau] = br_; sc_[2 * tau + 1] = kr_; } } } } while (0)
#define SCAN_POST(cc) do { const LAS float* yb_ = ybuf + ((cc) & 1) * 1024; const LAS float* bb_ = beta + ((cc) & 1) * 32; \
        const int tau = ht >> 3, r4 = (ht & 7) * 4, t_ = (cc) * 32 + tau; if (t_ < LP) { \
            const f32x4 y4 = *(const LAS f32x4*)(yb_ + tau * 32 + r4); \
            u32x2 w_; w_[0] = pk2(y4[0], y4[1]); w_[1] = pk2(y4[2], y4[3]); \
            *(u32x2*)(YR + (rowbase + t_) * DM + h * 64 + half * 32 + r4) = w_; \
            if (half == 0 && (ht & 7) == 0) BETA[(rowbase + t_) * 16 + h] = bb_[tau]; } } while (0)
        SCAN_LOAD(0);
        SCAN_BUILD(0);
        SCAN_LOAD(1);
        SCAN_BAR();
        for (int c = 0; c < nchunk; ++c) {
            if (c >= 1) SCAN_POST(c - 1);
            if (c + 1 < nchunk) SCAN_BUILD(c + 1);
            if (c + 2 < nchunk) SCAN_LOAD(c + 2);
            SCAN_BAR();
        }
        SCAN_POST(nchunk - 1);
#undef SCAN_LOAD
#undef SCAN_BUILD
#undef SCAN_POST
#undef SCAN_BAR
    }
}

__device__ __forceinline__ void scan_sample(const Args& a, LAS float* lds, int l, int s, int hh) {
    unsigned char* ws = a.ws;
    const bf16_t* PS = (const bf16_t*)(ws + OFF_PS); const bf16_t* Eb = (const bf16_t*)(ws + OFF_E); const bf16_t* Ab = (const bf16_t*)(ws + OFF_A);
    bf16_t* YR = (bf16_t*)(ws + OFF_YRAW); float* BETA = (float*)(ws + OFF_BETA);
    LAS float* vec = lds; LAS float* ybuf = lds + 32 * 384; LAS float* beta = ybuf + 32 * 64;
    const int tid = otid(), lane = tid & 63, wid = tid >> 6;
    const int hl = tid >> 4, c4 = (tid & 15) * 4, head = hh * 8 + hl, col = head * 64 + c4;
    const int rl = lane >> 3, cq = (lane & 7) * 4, vrow = wid * 8 + rl;
    const size_t row = (size_t)MP + s;
    __syncthreads();
    if (tid < 128) {
        const float* mus = a.in[11] + (size_t)l * DSHIFT; const float* sh = a.in[3] + ((size_t)l * NS + s) * DSHIFT;
        const bf16_t* bp = PS + row * DSHIFT + col;
        const u32x2 pr = *(const u32x2*)bp, pk = *(const u32x2*)(bp + 1024), pv = *(const u32x2*)(bp + 2048);
        const f32x4 qr = *(const f32x4*)(sh + col), qk = *(const f32x4*)(sh + 1024 + col), qv = *(const f32x4*)(sh + 2048 + col);
        const f32x4 mu_r = *(const f32x4*)(mus + col), mu_k = *(const f32x4*)(mus + 1024 + col), mu_v = *(const f32x4*)(mus + 2048 + col);
        const f32x4 kkc = *(const f32x4*)(a.in[17] + l * DM + col), kac = *(const f32x4*)(a.in[18] + l * DM + col), rkc = *(const f32x4*)(a.in[19] + l * DM + col);
        const u32x2 pe = *(const u32x2*)(Eb + row * DM + col), pa = *(const u32x2*)(Ab + row * DM + col);
        float r[4], k[4], v[4], e[4], aa[4];
        r[0] = bflo(pr[0]); r[1] = bfhi(pr[0]); r[2] = bflo(pr[1]); r[3] = bfhi(pr[1]);
        k[0] = bflo(pk[0]); k[1] = bfhi(pk[0]); k[2] = bflo(pk[1]); k[3] = bfhi(pk[1]);
        v[0] = bflo(pv[0]); v[1] = bfhi(pv[0]); v[2] = bflo(pv[1]); v[3] = bfhi(pv[1]);
        e[0] = bflo(pe[0]); e[1] = bfhi(pe[0]); e[2] = bflo(pe[1]); e[3] = bfhi(pe[1]);
        aa[0] = bflo(pa[0]); aa[1] = bfhi(pa[0]); aa[2] = bflo(pa[1]); aa[3] = bfhi(pa[1]);
        float kk[4], kh[4], ssq = 0.f, bpv = 0.f;
#pragma unroll
        for (int i = 0; i < 4; ++i) {
            r[i] += (qr[i] - r[i]) * mu_r[i]; k[i] += (qk[i] - k[i]) * mu_k[i]; v[i] += (qv[i] - v[i]) * mu_v[i];
            kk[i] = k[i] * kkc[i]; ssq += kk[i] * kk[i]; kh[i] = k[i] * (1.f + (aa[i] - 1.f) * kac[i]); bpv += r[i] * kh[i] * rkc[i];
        }
        ssq = red16(ssq); bpv = red16(bpv);
        const float inv = fminf(__builtin_amdgcn_rsqf(ssq), 1e12f);
        LAS float* vp = vec + hl * 384 + c4;
        *(LAS f32x4*)(vp) = (f32x4){r[0], r[1], r[2], r[3]};
        *(LAS f32x4*)(vp + 64) = (f32x4){__expf(e[0]), __expf(e[1]), __expf(e[2]), __expf(e[3])};
        *(LAS f32x4*)(vp + 128) = (f32x4){kh[0], kh[1], kh[2], kh[3]};
        *(LAS f32x4*)(vp + 192) = (f32x4){-kk[0] * inv, -kk[1] * inv, -kk[2] * inv, -kk[3] * inv};
        *(LAS f32x4*)(vp + 256) = (f32x4){kk[0] * inv * aa[0], kk[1] * inv * aa[1], kk[2] * inv * aa[2], kk[3] * inv * aa[3]};
        *(LAS f32x4*)(vp + 320) = (f32x4){v[0], v[1], v[2], v[3]};
        if ((tid & 15) == 0) beta[hl] = bpv;
    }
    __syncthreads();
    f32x4 st0[8], st1[8];
#pragma unroll
    for (int h8 = 0; h8 < 8; ++h8) {
        const float* sp = a.in[2] + ((((size_t)l * NS + s) * 16 + hh * 8 + h8) * 64 + vrow) * 64 + cq;
        st0[h8] = *(const f32x4*)sp; st1[h8] = *(const f32x4*)(sp + 32);
    }
#pragma unroll
    for (int h8 = 0; h8 < 8; ++h8) {
        const int h = hh * 8 + h8;
        const size_t so = ((((size_t)l * NS + s) * 16 + h) * 64 + vrow) * 64 + cq;
        const f32x4 s0 = st0[h8], s1 = st1[h8];
        float S[8] = {s0[0], s0[1], s0[2], s0[3], s1[0], s1[1], s1[2], s1[3]};
        const LAS float* vp = vec + h8 * 384 + cq;
        const f32x4 r0 = *(const LAS f32x4*)(vp), r1 = *(const LAS f32x4*)(vp + 32);
        const f32x4 w0 = *(const LAS f32x4*)(vp + 64), w1 = *(const LAS f32x4*)(vp + 96);
        const f32x4 k0 = *(const LAS f32x4*)(vp + 128), k1 = *(const LAS f32x4*)(vp + 160);
        const f32x4 a0 = *(const LAS f32x4*)(vp + 192), a1 = *(const LAS f32x4*)(vp + 224);
        const f32x4 b0 = *(const LAS f32x4*)(vp + 256), b1 = *(const LAS f32x4*)(vp + 288);
        const float vv = vec[h8 * 384 + 320 + vrow];
        float sa = 0.f;
#pragma unroll
        for (int j = 0; j < 4; ++j) { sa += S[j] * a0[j]; sa += S[4 + j] * a1[j]; }
        sa = red8(sa);
        float y = 0.f;
#pragma unroll
        for (int j = 0; j < 4; ++j) {
            S[j] = S[j] * w0[j] + sa * b0[j] + vv * k0[j]; S[4 + j] = S[4 + j] * w1[j] + sa * b1[j] + vv * k1[j];
            y += S[j] * r0[j]; y += S[4 + j] * r1[j];
        }
        y = red8(y);
        if ((lane & 7) == 0) ybuf[h8 * 64 + vrow] = y;
        float* dp = a.out + O_WKVS + so;
        *(f32x4*)dp = (f32x4){S[0], S[1], S[2], S[3]}; *(f32x4*)(dp + 32) = (f32x4){S[4], S[5], S[6], S[7]};
    }
    __syncthreads();
    if (tid < 128) {
        const f32x4 y4 = *(const LAS f32x4*)(ybuf + hl * 64 + c4);
        u32x2 w; w[0] = pk2(y4[0], y4[1]); w[1] = pk2(y4[2], y4[3]);
        *(u32x2*)(YR + row * DM + col) = w;
        if ((tid & 15) == 0) BETA[row * 16 + head] = beta[hl];
    }
}

__device__ __forceinline__ void phase_mix(const Args& a, int l) {
    unsigned char* ws = a.ws; bf16_t* PS = (bf16_t*)(ws + OFF_PS);
    const bf16_t* SAb = (const bf16_t*)(ws + OFF_E); const bf16_t* Qb = (const bf16_t*)(ws + OFF_A); const bf16_t* Ub = (const bf16_t*)(ws + OFF_PS) + 1024;
    const bf16_t* YR = (const bf16_t*)(ws + OFF_YRAW); const float* BETA = (const float*)(ws + OFF_BETA); const bf16_t* SA0 = (const bf16_t*)(ws + OFF_SA0);
    const float* cw = a.in[22] + (size_t)l * 3 * DM; const float* conv0 = a.in[4] + (size_t)l * NS * 2 * DM;
    const float* muv = a.in[11] + (size_t)l * DSHIFT + 2048; const float* sh0 = a.in[3] + (size_t)l * NS * DSHIFT + 2048;
    const float* lnw = a.in[20] + l * DM; const float* lnb = a.in[21] + l * DM;
    const int tid = otid();
    const int c8 = (tid & 127) * 8;
    float pm_[8], pw_[8], pb_[8], c0_[8], c1_[8], c2_[8];
    { const f32x4 a0 = *(const f32x4*)(muv + c8), a1 = *(const f32x4*)(muv + c8 + 4), b0 = *(const f32x4*)(lnw + c8), b1 = *(const f32x4*)(lnw + c8 + 4), d0 = *(const f32x4*)(lnb + c8), d1 = *(const f32x4*)(lnb + c8 + 4);
      const f32x4 e0 = *(const f32x4*)(cw + c8), e1 = *(const f32x4*)(cw + c8 + 4), f0 = *(const f32x4*)(cw + DM + c8), f1 = *(const f32x4*)(cw + DM + c8 + 4), g0 = *(const f32x4*)(cw + 2 * DM + c8), g1 = *(const f32x4*)(cw + 2 * DM + c8 + 4);
#pragma unroll
      for (int i = 0; i < 4; ++i) { pm_[i] = a0[i]; pm_[4 + i] = a1[i]; pw_[i] = b0[i]; pw_[4 + i] = b1[i]; pb_[i] = d0[i]; pb_[4 + i] = d1[i]; c0_[i] = e0[i]; c0_[4 + i] = e1[i]; c1_[i] = f0[i]; c1_[4 + i] = f1[i]; c2_[i] = g0[i]; c2_[4 + i] = g1[i]; } }
    struct MixIn { u32x4 g4, yr, vr, sa, q, u0, p1, p2, pv; f32x4 x0, x1, y0, y1, s0, s1; float bt; };
    auto mix_load = [&](int it, MixIn& r) {
        const int row = it >> 7;
        r.g4 = *(const u32x4*)((const bf16_t*)(ws + OFF_G) + (size_t)row * DM + c8);
        r.yr = *(const u32x4*)(YR + (size_t)row * DM + c8); r.vr = *(const u32x4*)(PS + (size_t)row * DSHIFT + 2048 + c8);
        r.sa = c8 < 256 ? *(const u32x4*)(SA0 + (size_t)row * 256 + c8) : *(const u32x4*)(SAb + (size_t)row * DM + c8);
        r.q = *(const u32x4*)(Qb + (size_t)row * DM + c8); r.u0 = *(const u32x4*)(Ub + (size_t)row * DSHIFT + c8);
        r.bt = BETA[(size_t)row * 16 + (c8 >> 6)];
        r.p1 = (u32x4){0u, 0u, 0u, 0u}; r.p2 = r.p1; r.pv = r.p1;
        if (row >= MP) {
            const float* c1 = conv0 + (size_t)((row - MP) * 2 + 1) * DM + c8; const float* c0 = conv0 + (size_t)((row - MP) * 2) * DM + c8;
            const float* sp = sh0 + (size_t)(row - MP) * DSHIFT + c8;
            r.x0 = *(const f32x4*)c1; r.x1 = *(const f32x4*)(c1 + 4); r.y0 = *(const f32x4*)c0; r.y1 = *(const f32x4*)(c0 + 4); r.s0 = *(const f32x4*)sp; r.s1 = *(const f32x4*)(sp + 4);
        } else {
            const int b = row / LP, t = row - b * LP;
            if (t >= 1) { r.p1 = *(const u32x4*)(Ub + (size_t)(row - 1) * DSHIFT + c8); r.pv = *(const u32x4*)(PS + (size_t)(row - 1) * DSHIFT + 2048 + c8); }
            if (t >= 2) r.p2 = *(const u32x4*)(Ub + (size_t)(row - 2) * DSHIFT + c8);
        }
    };
    auto mix_compute = [&](int it, const MixIn& r) {
        const int row = it >> 7;
        float u1[8], u2[8], vp[8];
        if (row >= MP) {
#pragma unroll
            for (int i = 0; i < 4; ++i) { u1[i] = r.x0[i]; u1[4 + i] = r.x1[i]; u2[i] = r.y0[i]; u2[4 + i] = r.y1[i]; vp[i] = r.s0[i]; vp[4 + i] = r.s1[i]; }
        } else {
#pragma unroll
            for (int i = 0; i < 4; ++i) { u1[2 * i] = bflo(r.p1[i]); u1[2 * i + 1] = bfhi(r.p1[i]); u2[2 * i] = bflo(r.p2[i]); u2[2 * i + 1] = bfhi(r.p2[i]); vp[2 * i] = bflo(r.pv[i]); vp[2 * i + 1] = bfhi(r.pv[i]); }
        }
        float y[8];
#pragma unroll
        for (int i = 0; i < 4; ++i) { y[2 * i] = bflo(r.yr[i]); y[2 * i + 1] = bfhi(r.yr[i]); }
        float s1 = ((y[0] + y[1]) + (y[2] + y[3])) + ((y[4] + y[5]) + (y[6] + y[7]));
        s1 = red8(s1);
        const float mean = s1 * (1.f / 64.f);
        float s2 = 0.f;
#pragma unroll
        for (int i = 0; i < 8; ++i) { y[i] -= mean; s2 += y[i] * y[i]; }
        s2 = red8(s2);
        const float rstd = rsqrtf(s2 * (1.f / 64.f) + 64e-5f);
        float o[8];
#pragma unroll
        for (int i = 0; i < 8; ++i) {
            const int w = i >> 1; const bool hi = i & 1;
            const float vraw = hi ? bfhi(r.vr[w]) : bflo(r.vr[w]);
            const float vv = vraw + (vp[i] - vraw) * pm_[i];
            const float sv = hi ? bfhi(r.sa[w]) : bflo(r.sa[w]), qv = hi ? bfhi(r.q[w]) : bflo(r.q[w]), uv = hi ? bfhi(r.u0[w]) : bflo(r.u0[w]);
            o[i] = (y[i] * rstd * pw_[i] + pb_[i] + r.bt * vv);
            const float z = c0_[i] * u2[i] + c1_[i] * u1[i] + c2_[i] * uv;
            y[i] = qv * z; u1[i] = sv;
        }
        u32x4 w;
#pragma unroll
        for (int i = 0; i < 4; ++i) { const float m0 = u1[2 * i] * (o[2 * i] * bflo(r.g4[i])) + y[2 * i], m1 = u1[2 * i + 1] * (o[2 * i + 1] * bfhi(r.g4[i])) + y[2 * i + 1]; w[i] = pk2(m0, m1); }
        *(u32x4*)(PS + (size_t)row * DSHIFT + c8) = w;
    };
    const int step = gridDim.x * 512, total = M * 128;
    for (int it = blockIdx.x * 512 + tid; it < total; it += 2 * step) {
        MixIn A, B;
        const bool hasB = it + step < total;
        mix_load(it, A);
        if (hasB) mix_load(it + step, B);
        mix_compute(it, A);
        if (hasB) mix_compute(it + step, B);
    }
}

__device__ __forceinline__ void phase_final(const Args& a) {
    unsigned char* ws = a.ws; const bf16_t* XB = (const bf16_t*)(ws + OFF_E);
    const float* SS = (const float*)(ws + OFF_SS); const float* nf = a.in[27];
    const int tid = otid(), lane = tid & 63, wid = tid >> 6;
    f32x4 g[4];
#pragma unroll
    for (int i = 0; i < 4; ++i) g[i] = *(const f32x4*)(nf + lane * 4 + i * 256);
    auto dst_of = [&](int row) -> float* {
        if (row >= M) return nullptr;
        if (row >= MP) return a.out + O_YS + (size_t)(row - MP) * DM;
        const int b = row / LP, t = row - b * LP; if (t < NMETA) return nullptr;
        return a.out + O_YP + ((size_t)b * SEQ + (t - NMETA)) * DM; };
    for (int row = blockIdx.x * 8 + wid; row < M; row += 2 * gridDim.x * 8) {
        const int rowB = row + gridDim.x * 8;
        float* dA = dst_of(row); float* dB = dst_of(rowB);
        u32x2 hA[4], hB[4]; float rsA = 0.f, rsB = 0.f;
        if (dA) { rsA = row_rstd(SS, row);
#pragma unroll
            for (int i = 0; i < 4; ++i) hA[i] = *(const u32x2*)(XB + (size_t)row * DM + lane * 4 + i * 256); }
        if (dB) { rsB = row_rstd(SS, rowB);
#pragma unroll
            for (int i = 0; i < 4; ++i) hB[i] = *(const u32x2*)(XB + (size_t)rowB * DM + lane * 4 + i * 256); }
        if (dA) {
#pragma unroll
            for (int i = 0; i < 4; ++i) { const f32x4 v = (f32x4){bflo(hA[i][0]), bfhi(hA[i][0]), bflo(hA[i][1]), bfhi(hA[i][1])}; *(f32x4*)(dA + lane * 4 + i * 256) = v * rsA * g[i]; } }
        if (dB) {
#pragma unroll
            for (int i = 0; i < 4; ++i) { const f32x4 v = (f32x4){bflo(hB[i][0]), bfhi(hB[i][0]), bflo(hB[i][1]), bfhi(hB[i][1])}; *(f32x4*)(dB + lane * 4 + i * 256) = v * rsB * g[i]; } }
    }
}

__device__ __forceinline__ void gemm_tail_res(LAS float* ldsf, const bf16_t* A, int lda, const bf16_t* Bt, int K, const bf16_t* XB, bf16_t* XBo, float* SS, float scale) {
    const int tid = otid(), lane = tid & 63, wid = tid >> 6;
    const int kw = K >> 3;
    for (int su = blockIdx.x; su < 256; su += gridDim.x) {
        const int row0 = 16384 + (su >> 4) * 16, col0 = (su & 15) * 64;
        f32x4 acc[4];
#pragma unroll
        for (int n = 0; n < 4; ++n) acc[n] = (f32x4){0.f, 0.f, 0.f, 0.f};
        const bf16_t* ap = A + (size_t)(row0 + (lane & 15)) * lda + wid * kw + (lane >> 4) * 8;
        const bf16_t* bp = Bt + (size_t)(col0 + (lane & 15)) * K + wid * kw + (lane >> 4) * 8;
        for (int ks = 0; ks < kw; ks += 32) {
            const bf16x8 af = *(const bf16x8*)(ap + ks);
#pragma unroll
            for (int n = 0; n < 4; ++n) { const bf16x8 bfr = *(const bf16x8*)(bp + (size_t)n * 16 * K + ks); acc[n] = __builtin_amdgcn_mfma_f32_16x16x32_bf16(af, bfr, acc[n], 0, 0, 0); }
        }
#pragma unroll
        for (int n = 0; n < 4; ++n)
#pragma unroll
            for (int j = 0; j < 4; ++j) ldsf[wid * 1024 + ((lane >> 4) * 4 + j) * 64 + n * 16 + (lane & 15)] = acc[n][j];
        __syncthreads();
        { const int r = tid >> 5, c = (tid & 31) * 2; float s0 = 0.f, s1 = 0.f;
#pragma unroll
          for (int w = 0; w < 8; ++w) { const f32x2 v = *(const LAS f32x2*)(ldsf + w * 1024 + r * 64 + c); s0 += v[0]; s1 += v[1]; }
          const size_t o = (size_t)(row0 + r) * DM + col0 + c;
          const unsigned hi = *(const unsigned*)(XB + o);
          f32x2 x; x[0] = bflo(hi) + scale * s0; x[1] = bfhi(hi) + scale * s1;
          *(unsigned*)(XBo + o) = pk2(x[0], x[1]);
          float ss = x[0] * x[0] + x[1] * x[1]; ss = red16(ss); ss += __shfl_xor(ss, 16);
          if ((tid & 31) == 0) SS[(size_t)(row0 + r) * 16 + (su & 15)] = ss; }
        __syncthreads();
    }
}

#define XB_TMO      128
#define XB_XCNT(j)  (256  + 64 * (j))
#define XB_XSUB(j)  (1280 + 64 * (j))
#define XB_XGEN(j)  (2304 + 64 * (j))
#define XB_TOP      3328
#define XB_TOPGEN   3392
#define XCD_BAR_WORDS 3456
#define XB_SPIN_CAP (1u << 18)
__device__ __forceinline__ unsigned xb_ld(unsigned* p)              { return __hip_atomic_load(p, __ATOMIC_RELAXED, __HIP_MEMORY_SCOPE_AGENT); }
__device__ __forceinline__ unsigned xb_add(unsigned* p, unsigned v) { return __hip_atomic_fetch_add(p, v, __ATOMIC_RELAXED, __HIP_MEMORY_SCOPE_AGENT); }
__device__ __forceinline__ unsigned xb_xcc_id() { return (unsigned)__builtin_amdgcn_s_getreg((3 << 11) | 20) & 0xFu; }
#define XB_SPIN(cond, bar) do { unsigned _sp = 0; while (cond) { __builtin_amdgcn_s_sleep(1); \
    if ((++_sp & 255u) == 0u) { if (xb_ld(&(bar)[XB_TMO])) break; if (_sp > XB_SPIN_CAP) { atomicAdd(&(bar)[XB_TMO], 1u); break; } } } } while (0)
struct XcdBarrier { unsigned* bar; unsigned x; volatile LAS unsigned* st; };
__device__ __forceinline__ XcdBarrier xcd_barrier_post(unsigned* bar, volatile LAS unsigned* st) {
    XcdBarrier b; b.bar = bar; b.x = xb_xcc_id(); b.st = st;
    if (threadIdx.x == 0) (void)xb_add(&bar[XB_XCNT(b.x)], 1u);
    return b;
}
__device__ __forceinline__ void xcd_barrier_complete(unsigned* bar, unsigned x, unsigned& nloc, unsigned& nx) {
    const unsigned G = gridDim.x * gridDim.y * gridDim.z;
    unsigned sum, cnt, mine, sp = 0u;
    for (;;) {
        sum = 0u; cnt = 0u; mine = 0u;
#pragma unroll
        for (unsigned j = 0; j < 16; ++j) { const unsigned c = xb_ld(&bar[XB_XCNT(j)]); sum += c; cnt += (c > 0u) ? 1u : 0u; mine = (j == x) ? c : mine; }
        if (sum == G) break;
        __builtin_amdgcn_s_sleep(1);
        if ((++sp & 255u) == 0u) { if (xb_ld(&bar[XB_TMO])) break; if (sp > XB_SPIN_CAP) { atomicAdd(&bar[XB_TMO], 1u); break; } }
    }
    nloc = mine > 0u ? mine : 1u; nx = cnt > 0u ? cnt : 1u;
}
__device__ __forceinline__ void xcd_barrier(const XcdBarrier& b) {
    asm volatile("s_waitcnt vmcnt(0)" ::: "memory");
    __syncthreads();
    if (threadIdx.x == 0) {
        unsigned* bar = b.bar;
        __builtin_amdgcn_s_waitcnt(0);
        unsigned nloc = b.st[0], nx = b.st[1];
        if (nloc == 0u) { xcd_barrier_complete(bar, b.x, nloc, nx); b.st[0] = nloc; b.st[1] = nx; }
        const unsigned old = xb_add(&bar[XB_XSUB(b.x)], 1u);
        const unsigned gen = old / nloc;
        if (old + 1u == (gen + 1u) * nloc) {
            __builtin_amdgcn_fence(__ATOMIC_RELEASE, "agent");
            asm volatile("s_waitcnt vmcnt(0)" ::: "memory");
            const unsigned og = xb_add(&bar[XB_TOP], 1u);
            const unsigned tg = og / nx;
            if (og + 1u == (tg + 1u) * nx) xb_add(&bar[XB_TOPGEN], 1u);
            else XB_SPIN(xb_ld(&bar[XB_TOPGEN]) == tg, bar);
            __builtin_amdgcn_fence(__ATOMIC_ACQUIRE, "agent");
            xb_add(&bar[XB_XGEN(b.x)], 1u);
            asm volatile("s_waitcnt vmcnt(0)" ::: "memory");
        } else {
            XB_SPIN(xb_ld(&bar[XB_XGEN(b.x)]) == gen, bar);
            __builtin_amdgcn_fence(__ATOMIC_ACQUIRE, "agent");
            asm volatile("s_waitcnt vmcnt(0)" ::: "memory");
        }
    }
    __syncthreads();
}

__global__ void __launch_bounds__(512, 2) hybrid_fwd(Args a) {
    extern __shared__ __attribute__((aligned(16))) unsigned char shm_raw[];
    LAS unsigned char* lds = (LAS unsigned char*)shm_raw;
    LAS float* ldsf = (LAS float*)shm_raw;
    cg::grid_group grid = cg::this_grid();
    unsigned char* ws = a.ws;
    volatile LAS unsigned* bst = (volatile LAS unsigned*)(shm_raw + 131072);
    if (threadIdx.x == 0) { bst[0] = 0u; bst[1] = 0u; }
    __syncthreads();
    const XcdBarrier xb = xcd_barrier_post((unsigned*)(ws + OFF_BAR), bst);
    bf16_t* XB = (bf16_t*)a.out; float* SS = (float*)(ws + OFF_SS);
    LAS float* RT = (LAS float*)(shm_raw + LDS_RSTD);
    pg8::StaticOrder S;
    for (int ph = a.ph_lo; ph < a.ph_hi; ++ph) {
      int reps = 1;
#if DUP_MASK
      { const int i_ = (ph - 1) % 11, l_ = (ph - 1) / 11; (void)l_;
        if (ph == 0) { if (DUP_MASK & 1) reps = 2; }
        else if (ph != NPHASE - 1) { if (((DUP_MASK & 2) && (i_ == 0 || i_ == 9)) || ((DUP_MASK & 4) && i_ == 2) || ((DUP_MASK & 8) && i_ == 3) || ((DUP_MASK & 16) && i_ == 4) || ((DUP_MASK & 32) && i_ == 6) || ((DUP_MASK & 64) && i_ == 5) || ((DUP_MASK & 128) && i_ == 7 && l_ == 1)) reps = 2; } }
#endif
      for (int rep = 0; rep < reps; ++rep) {
        if (ph == 0) phase_prologue(a, ldsf);
        else if (ph == NPHASE - 1) phase_final(a);
        else {
            const int l = (ph - 1) / 11, i = (ph - 1) % 11;
            { const int Nph = (i == 0 || i == 9) ? 2 * DFF : (i == 2 ? DSHIFT + 256 : (i == 6 ? 4864 : 0));
              if (Nph) { S.init(M, Nph, gridDim.x, blockIdx.x); prep_rstd(RT, SS, S); } }
            switch (i) {
            case 0: case 9: {
                pg8::Gemm g{XB, (const bf16_t*)(ws + (i == 0 ? OFF_W1 : OFF_W5)), M, 2 * DFF, DM, DM};
                S.init(M, 2 * DFF, gridDim.x, blockIdx.x);
                EpiFfnIn E{RT, (bf16_t*)(ws + OFF_H)};
                pg8::gemm_phase<EpiFfnIn>(lds, g, S, E);
            } break;
            case 1: case 8: case 10: {
                const bool wo = (i == 8);
                pg8::Gemm g{(const bf16_t*)(ws + (wo ? OFF_PS : OFF_H)), (const bf16_t*)(ws + (i == 1 ? OFF_W2 : (wo ? OFF_WO : OFF_W6))), M, DM, wo ? DM : DFF, wo ? DSHIFT : DFF};
                S.init(M - 256, DM, gridDim.x, blockIdx.x);
                const bool fin = (l == 1 && i == 10);
                bf16_t* xbo = fin ? (bf16_t*)(ws + OFF_E) : XB;
                EpiRes E{XB, xbo, SS, wo ? 1.f : 0.5f};
                pg8::gemm_phase<EpiRes>(lds, g, S, E);
                gemm_tail_res(ldsf, g.A, g.lda, g.Bt, g.K, XB, xbo, SS, wo ? 1.f : 0.5f);
            } break;
            case 2: {
                pg8::Gemm g{XB, (const bf16_t*)(ws + OFF_WIN), M, DSHIFT + 256, DM, DM};
                S.init(M, DSHIFT + 256, gridDim.x, blockIdx.x);
                EpiPS E{RT, (bf16_t*)(ws + OFF_PS), a.out + O_SHP + (size_t)l * NB * DSHIFT, a.out + O_SHS + (size_t)l * NS * DSHIFT, (bf16_t*)(ws + OFF_SA0)};
                pg8::gemm_phase<EpiPS>(lds, g, S, E);
            } break;
            case 3:
                phase_lbuild(a, l);
                break;
            case 4: {
                pg8::Gemm g{(const bf16_t*)(ws + OFF_L), (const bf16_t*)(ws + OFF_WL + (size_t)l * SZ_WL), M, 3072, 256, 256};
                S.init(M, 3072, gridDim.x, blockIdx.x);
                EpiLora E{(bf16_t*)(ws + OFF_E), (bf16_t*)(ws + OFF_A), (bf16_t*)(ws + OFF_G), a.in[12] + l * DM, a.in[14] + l * DM};
                pg8::gemm_phase<EpiLora>(lds, g, S, E);
            } break;
            case 5:
                for (int u = blockIdx.x; u < 512; u += gridDim.x) { if (u < 256) scan_prompt(a, ldsf, l, u >> 5, (u >> 1) & 15, u & 1); else scan_sample(a, ldsf, l, (u - 256) >> 1, u & 1); }
                break;
            case 6: {
                pg8::Gemm g{XB, (const bf16_t*)(ws + OFF_WIN + (size_t)(DSHIFT + 256) * DM * 2), M, 4864, DM, DM};
                S.init(M, 4864, gridDim.x, blockIdx.x);
                EpiCG E{RT, (bf16_t*)(ws + OFF_E), (bf16_t*)(ws + OFF_A), (bf16_t*)(ws + OFF_PS) + 1024, a.out + O_CVP + (size_t)l * NB * 2 * DM, a.out + O_CVS + (size_t)l * NS * 2 * DM,
                        a.in[4] + (size_t)l * NS * 2 * DM};
                pg8::gemm_phase<EpiCG>(lds, g, S, E);
            } break;
            case 7:
                phase_mix(a, l);
                break;
            }
        }
      }
        {
            unsigned jobs = 0u;
            if (ph == 0) jobs = 0x3Fu;
            else if (ph != NPHASE - 1) {
                const int l = (ph - 1) / 11, i = (ph - 1) % 11;
                if (l == 0 && i == 7) jobs = 0x7u << 6;
                else if (l == 1 && i == 3) jobs = 0x38u << 6;
            }
            if (jobs) conv_jobs(a, ldsf, jobs, blockIdx.x, gridDim.x);
        }
        if (ph + 1 < a.ph_hi) { if (a.ph_lo < 0) grid.sync(); else xcd_barrier(xb); }
    }
}

extern "C" void kernel_launch(void* const* d_in, const int* in_sizes, int n_in, void* d_out, int out_size, void* d_ws, size_t ws_size, hipStream_t stream) {
    static int grid = 0;
    if (grid == 0) {
        if (n_in != 28 || (size_t)out_size != O_END || ws_size < WS_END) {
            fprintf(stderr, "kernel_launch: unexpected shapes: n_in %d out_size %d ws_size %zu (need %zu)\n", n_in, out_size, ws_size, (size_t)WS_END); grid = -1; return; }
        int dev = 0, cus = 0, per_cu = 0;
        if (hipGetDevice(&dev) != hipSuccess || hipDeviceGetAttribute(&cus, hipDeviceAttributeMultiprocessorCount, dev) != hipSuccess) { grid = -1; return; }
        if (hipFuncSetAttribute((const void*)hybrid_fwd, hipFuncAttributeMaxDynamicSharedMemorySize, LDS_BYTES) != hipSuccess) { fprintf(stderr, "kernel_launch: hipFuncSetAttribute failed\n"); grid = -1; return; }
        if (hipOccupancyMaxActiveBlocksPerMultiprocessor(&per_cu, (const void*)hybrid_fwd, 512, LDS_BYTES) != hipSuccess || per_cu < 1) { fprintf(stderr, "kernel_launch: occupancy query failed (%d)\n", per_cu); grid = -1; return; }
        grid = cus;
    }
    if (grid < 0) return;
    if (hipMemsetAsync((char*)d_ws + OFF_BAR, 0, 16384, stream) != hipSuccess) { fprintf(stderr, "kernel_launch: memset of barrier words failed\n"); return; }
    Args a{};
    for (int i = 0; i < 28; ++i) a.in[i] = (const float*)d_in[i];
    a.out = (float*)d_out; a.ws = (unsigned char*)d_ws; a.ph_lo = 0; a.ph_hi = NPHASE;
    void* args[] = {&a};
    hipError_t e = hipLaunchCooperativeKernel((const void*)hybrid_fwd, dim3(grid), dim3(512), args, LDS_BYTES, stream);
    if (e != hipSuccess) fprintf(stderr, "kernel_launch: cooperative launch failed: %s (grid %d)\n", hipGetErrorString(e), grid);
}
```
